# Optimizing an MI355X kernel written in HIP

```python
import jax, jax.numpy as jnp
from jax import lax
import numpy as np

D_MODEL = 4096
BATCH = 4
SEQ = 4096
DEPTH = 1

CHUNK = 64
Q_BLOCK = 128
PLE_DIM = 256
RET_HEADS = 8
RET_HEAD_DIM = D_MODEL // (2 * RET_HEADS)
RET_WIDTH = RET_HEADS * RET_HEAD_DIM
MLA_HEADS = 16
MLA_NOPE = 128
MLA_ROPE = 64
MLA_V = (D_MODEL - RET_WIDTH) // MLA_HEADS
Q_LORA = D_MODEL // 4
KV_LORA = D_MODEL // 8
D_FF = ((8 * D_MODEL // 3 + 255) // 256) * 256
CONV_WIDTH = 3
ROPE_BASE = 10000.0
EPS = 1e-6
IN_WIDTH = 4 * RET_WIDTH + Q_LORA + KV_LORA + MLA_ROPE
IN_SPLITS = (RET_WIDTH, 2 * RET_WIDTH, 3 * RET_WIDTH, 4 * RET_WIDTH,
             4 * RET_WIDTH + Q_LORA, 4 * RET_WIDTH + Q_LORA + KV_LORA)

kernel_name = "hybrid_retention_mla_convffn_ple"


def rms_norm(x, g):
    xf = x.astype(jnp.float32)
    y = xf * lax.rsqrt(jnp.mean(xf * xf, axis=-1, keepdims=True) + EPS)
    return (y * g.astype(jnp.float32)).astype(x.dtype)


def head_norm(o):
    of = o.astype(jnp.float32)
    mu = jnp.mean(of, axis=-1, keepdims=True)
    var = jnp.mean(jnp.square(of - mu), axis=-1, keepdims=True)
    return ((of - mu) * lax.rsqrt(var + EPS)).astype(o.dtype)


def rope_tables(seq, dim):
    inv = 1.0 / (ROPE_BASE ** (jnp.arange(0, dim, 2, dtype=jnp.float32) / dim))
    ang = jnp.arange(seq, dtype=jnp.float32)[:, None] * inv[None, :]
    return jnp.cos(ang), jnp.sin(ang)


def apply_rope(x, cos, sin):
    x1, x2 = jnp.split(x, 2, axis=-1)
    c = cos[None, :, None, :].astype(x.dtype)
    s = sin[None, :, None, :].astype(x.dtype)
    return jnp.concatenate([x1 * c - x2 * s, x2 * c + x1 * s], axis=-1)


def retention(q, k, v):
    B, S, H, dk = q.shape
    dv = v.shape[-1]
    nC = S // CHUNK
    dt = q.dtype
    log_g = jnp.log1p(-jnp.exp2(-5.0 - jnp.arange(H, dtype=jnp.float32)))
    idx = jnp.arange(CHUNK, dtype=jnp.float32)
    inner = jnp.exp(log_g[:, None, None] * jnp.abs(idx[:, None] - idx[None, :])).astype(dt)
    q_dec = jnp.exp(log_g[:, None] * (idx + 1.0))[..., None].astype(dt)
    k_dec = jnp.exp(log_g[:, None] * (CHUNK - 1.0 - idx))[..., None].astype(dt)
    s_dec = jnp.exp(log_g * CHUNK)[:, None, None].astype(dt)
    k = k * (dk ** -0.5)

    def to_chunks(t):
        return t.reshape(B, nC, CHUNK, H, t.shape[-1]).transpose(1, 0, 3, 2, 4)

    def step(state, qkv):
        qc, kc, vc = qkv
        scores = jnp.einsum('bhnd,bhmd->bhnm', qc, kc) * inner
        out = (jnp.einsum('bhnm,bhmv->bhnv', scores, vc)
               + jnp.einsum('bhnd,bhdv->bhnv', qc * q_dec, state))
        state = state * s_dec + jnp.einsum('bhmd,bhmv->bhdv', kc * k_dec, vc)
        return state, out

    s0 = jnp.zeros((B, H, dk, dv), dt)
    _, out = lax.scan(step, s0, (to_chunks(q), to_chunks(k), to_chunks(v)))
    return out.transpose(1, 0, 3, 2, 4).reshape(B, S, H, dv)


def mla_attention(q_nope, q_rope, k_nope, k_rope, v):
    B, S, H, _ = q_nope.shape
    nQ = S // Q_BLOCK
    scale = (MLA_NOPE + MLA_ROPE) ** -0.5
    key_chunk = jnp.arange(S) // CHUNK

    def blocks(t):
        return t.reshape(B, nQ, Q_BLOCK, *t.shape[2:]).swapaxes(0, 1)

    def one_block(args):
        qn, qr, b = args
        s = (jnp.einsum('bqhd,bkhd->bhqk', qn, k_nope)
             + jnp.einsum('bqhr,bkr->bhqk', qr, k_rope)).astype(jnp.float32) * scale
        q_chunk = (b * Q_BLOCK + jnp.arange(Q_BLOCK)) // CHUNK
        mask = key_chunk[None, :] <= q_chunk[:, None]
        s = jnp.where(mask[None, None], s, -jnp.inf)
        w = jax.nn.softmax(s, axis=-1).astype(v.dtype)
        return jnp.einsum('bhqk,bkhv->bqhv', w, v)

    out = lax.map(one_block, (blocks(q_nope), blocks(q_rope), jnp.arange(nQ)))
    return out.swapaxes(0, 1).reshape(B, S, H, v.shape[-1])


def causal_dwconv(h, w, b):
    S = h.shape[1]
    hp = jnp.pad(h, ((0, 0), (CONV_WIDTH - 1, 0), (0, 0)))
    out = b
    for j in range(CONV_WIDTH):
        out = out + hp[:, j:j + S, :] * w[j]
    return out


def setup_inputs(seed: int = 0) -> dict:
    key = jax.random.key(seed)
    ks = jax.random.split(key, 20)

    def nrm(k, shape, fan_in):
        return jax.random.normal(k, shape, jnp.float32) * (fan_in ** -0.5)

    def gain(k, shape):
        return 1.0 + 0.01 * jax.random.normal(k, shape, jnp.float32)

    L = DEPTH
    return {
        "x": jax.random.normal(ks[0], (BATCH, SEQ, D_MODEL), jnp.float32),
        "p": jax.random.normal(ks[1], (DEPTH, BATCH, SEQ, PLE_DIM), jnp.float32),
        "w_in": nrm(ks[2], (L, D_MODEL, IN_WIDTH), D_MODEL),
        "g_attn": gain(ks[3], (L, D_MODEL)),
        "g_q_lora": gain(ks[4], (L, Q_LORA)),
        "g_kv_lora": gain(ks[5], (L, KV_LORA)),
        "w_uq": nrm(ks[6], (L, Q_LORA, MLA_HEADS * (MLA_NOPE + MLA_ROPE)), Q_LORA),
        "w_ukv": nrm(ks[7], (L, KV_LORA, MLA_HEADS * (MLA_NOPE + MLA_V)), KV_LORA),
        "w_o": nrm(ks[8], (L, RET_WIDTH + MLA_HEADS * MLA_V, D_MODEL), D_MODEL),
        "g_ffn": gain(ks[9], (L, D_MODEL)),
        "w_ffn_gate": nrm(ks[10], (L, D_MODEL, D_FF), D_MODEL),
        "w_ffn_up": nrm(ks[11], (L, D_MODEL, D_FF), D_MODEL),
        "conv_w": nrm(ks[12], (L, CONV_WIDTH, D_FF), CONV_WIDTH),
        "conv_b": 0.01 * jax.random.normal(ks[13], (L, D_FF), jnp.float32),
        "w_ffn_down": nrm(ks[14], (L, D_FF, D_MODEL), D_FF),
        "g_ple": gain(ks[15], (L, D_MODEL)),
        "w_ple_gate": nrm(ks[16], (L, D_MODEL, D_MODEL), D_MODEL),
        "w_ple_proj": nrm(ks[17], (L, PLE_DIM, D_MODEL), PLE_DIM),
        "g_final": gain(ks[18], (D_MODEL,)),
    }


def reference(x, p, w_in, g_attn, g_q_lora, g_kv_lora, w_uq, w_ukv, w_o, g_ffn,
              w_ffn_gate, w_ffn_up, conv_w, conv_b, w_ffn_down, g_ple,
              w_ple_gate, w_ple_proj, g_final):
    B, S, _ = x.shape
    cos_r, sin_r = rope_tables(S, RET_HEAD_DIM)
    cos_m, sin_m = rope_tables(S, MLA_ROPE)
    h = x
    for i in range(DEPTH):
        hn = rms_norm(h, g_attn[i])
        proj = hn @ w_in[i]
        rq, rk, rv, rg, cq, ckv, kr = jnp.split(proj, IN_SPLITS, axis=-1)

        rq = apply_rope(rq.reshape(B, S, RET_HEADS, RET_HEAD_DIM), cos_r, sin_r)
        rk = apply_rope(rk.reshape(B, S, RET_HEADS, RET_HEAD_DIM), cos_r, sin_r)
        rv = rv.reshape(B, S, RET_HEADS, RET_HEAD_DIM)
        ro = head_norm(retention(rq, rk, rv)).reshape(B, S, RET_WIDTH)
        ro = jax.nn.silu(rg) * ro

        q = (rms_norm(cq, g_q_lora[i]) @ w_uq[i]).reshape(B, S, MLA_HEADS, MLA_NOPE + MLA_ROPE)
        q_nope = q[..., :MLA_NOPE]
        q_rope = apply_rope(q[..., MLA_NOPE:], cos_m, sin_m)
        kv = (rms_norm(ckv, g_kv_lora[i]) @ w_ukv[i]).reshape(B, S, MLA_HEADS, MLA_NOPE + MLA_V)
        k_nope = kv[..., :MLA_NOPE]
        v = kv[..., MLA_NOPE:]
        k_rope = apply_rope(kr[:, :, None, :], cos_m, sin_m)[:, :, 0, :]
        mo = mla_attention(q_nope, q_rope, k_nope, k_rope, v).reshape(B, S, MLA_HEADS * MLA_V)

        h = h + jnp.concatenate([ro, mo], axis=-1) @ w_o[i]

        hn = rms_norm(h, g_ffn[i])
        a = causal_dwconv(hn @ w_ffn_gate[i], conv_w[i], conv_b[i])
        h = h + (jax.nn.silu(a) * (hn @ w_ffn_up[i])) @ w_ffn_down[i]

        gate = jax.nn.sigmoid(rms_norm(h, g_ple[i]) @ w_ple_gate[i])
        h = h + gate * (p[i] @ w_ple_proj[i])
    return rms_norm(h, g_final)
```

```cpp
#include <hip/hip_runtime.h>
#include <cstdio>
#include <cstdint>
namespace pg8 {
#define PG8_LAS __attribute__((address_space(3)))
typedef unsigned short bf16_t;
typedef short bf16x8 __attribute__((ext_vector_type(8)));
typedef float f32x4 __attribute__((ext_vector_type(4)));
typedef unsigned u32x4 __attribute__((ext_vector_type(4)));
constexpr int BM = 256, BK = 64, HALF = 128, HTB = HALF * BK * 2  , STAGE_BYTES = 8 * HTB, NXCD = 8, WGM = 8;

__host__ __device__ __forceinline__ int lds_byte(int r, int c) { const int st = (r >> 4) * 2 + (c >> 5), rr = r & 15, cc = c & 31, ob = rr * 64 + cc * 2; return st * 1024 + (ob ^ (((ob >> 9) & 1) << 5)); }
__host__ __device__ __forceinline__ void stage_rc(int b, int& R, int& C) { const int st = b / 1024, sb = b % 1024, swz = sb ^ (((sb >> 9) & 1) << 5); R = (st >> 1) * 16 + swz / 64; C = (st & 1) * 32 + (swz % 64) / 2; }
__host__ __device__ __forceinline__ int perm32(int rho) { const int n = rho >> 4, i = rho & 15; return 8 * (i >> 2) + 4 * n + (i & 3); }

struct Unit { int pm, pn; };
struct Gemm { const bf16_t* A; const bf16_t* Bt; int M, N, K, lda, ldb; };

struct StaticOrder {
    int nM, nN, nwg, G, c;
    __host__ __device__ void init(int M, int N, int G_, int c_) { nM = M / BM; nN = N / BM; nwg = nM * nN; G = G_; c = c_; }
    __host__ __device__ bool next(int i, Unit& u) const {
        const long L = (long)i * G + c; if (L >= nwg) return false;
        int wgid = (int)L; { const int q = nwg / NXCD, r = nwg % NXCD, xcd = wgid % NXCD, off = wgid / NXCD; wgid = (xcd < r ? xcd * (q + 1) : r * (q + 1) + (xcd - r) * q) + off; }
        const int nig = WGM * nN, gid = wgid / nig, fm = gid * WGM, gsz = (nM - fm) < WGM ? (nM - fm) : WGM;
        u.pm = fm + ((wgid % nig) % gsz); u.pn = (wgid % nig) / gsz; return true;
    }
    __device__ __forceinline__ void a_ready(const Unit&) const {}
    __device__ __forceinline__ void done(const Unit&) const {}
};

typedef float f32x2c_t __attribute__((ext_vector_type(2))); typedef __bf16 bf16x2c_t __attribute__((ext_vector_type(2)));
__device__ __forceinline__ unsigned cvt_pk_bf16(float lo, float hi) { f32x2c_t v = {lo, hi}; bf16x2c_t b = __builtin_convertvector(v, bf16x2c_t); return __builtin_bit_cast(unsigned, b); }
typedef float f32x2 __attribute__((ext_vector_type(2)));

typedef unsigned u32x2 __attribute__((ext_vector_type(2)));
constexpr float RMS_EPS = 1e-6f;
__device__ __forceinline__ u32x4 pack8(const f32x4 a, const f32x4 b) { u32x4 w; w.x = cvt_pk_bf16(a[0], a[1]); w.y = cvt_pk_bf16(a[2], a[3]); w.z = cvt_pk_bf16(b[0], b[1]); w.w = cvt_pk_bf16(b[2], b[3]); return w; }
__device__ __forceinline__ float sumsq4(const f32x4 a) { return (a[0] * a[0] + a[1] * a[1]) + (a[2] * a[2] + a[3] * a[3]); }
__device__ __forceinline__ float quad_row_sum(float s) { s += __shfl_xor(s, 16); s += __shfl_xor(s, 32); return s; }
__device__ __forceinline__ void atomic_add_f32(float* p, float v) { unsafeAtomicAdd(p, v); }
__device__ __forceinline__ float bf_lo(unsigned w) { return __uint_as_float(w << 16); }
__device__ __forceinline__ float bf_hi(unsigned w) { return __uint_as_float(w & 0xffff0000u); }
__device__ __forceinline__ u32x2 pack8_fp8(const f32x4 a, const f32x4 b) {
    int w0 = __builtin_amdgcn_cvt_pk_fp8_f32(a[0], a[1], 0, false); w0 = __builtin_amdgcn_cvt_pk_fp8_f32(a[2], a[3], w0, true);
    int w1 = __builtin_amdgcn_cvt_pk_fp8_f32(b[0], b[1], 0, false); w1 = __builtin_amdgcn_cvt_pk_fp8_f32(b[2], b[3], w1, true);
    u32x2 r; r.x = (unsigned)w0; r.y = (unsigned)w1; return r; }
constexpr float WQ8_SCALE = 32.0f;
constexpr float W8_SCALE = 64.0f;

struct EpiPlain {
    static constexpr bool PERM = true, AFTER_DRAIN = false;
    bf16_t* O; int ldc;
    __device__ __forceinline__ void operator()(const f32x4 (&acc)[2][2][4][2], const Unit& u, int wr, int wc, int fr, int fq) const {
        const int row0 = u.pm * BM + wr * 64 + fr, col0 = u.pn * BM + wc * 32 + 8 * fq;
#pragma unroll
        for (int ai = 0; ai < 2; ++ai)
#pragma unroll
            for (int m = 0; m < 4; ++m) { bf16_t* rowp = O + (size_t)(row0 + ai * HALF + m * 16) * ldc + col0;
#pragma unroll
                for (int bj = 0; bj < 2; ++bj) *(u32x4*)(rowp + bj * HALF) = pack8(acc[ai][bj][m][0], acc[ai][bj][m][1]); }
    }
};

struct EpiProj {
    static constexpr bool PERM = true, AFTER_DRAIN = false;
    bf16_t* P; int ldp; const float* cosR; const float* sinR;
    __device__ __forceinline__ void operator()(const f32x4 (&acc)[2][2][4][2], const Unit& u, int wr, int wc, int fr, int fq) const {
        const int row0 = u.pm * BM + wr * 64 + fr, cl = wc * 32 + 8 * fq, pn = u.pn;
        if (pn < 16) {
            const float sc = pn >= 8 ? 0.0625f : 1.0f;
            constexpr int DEPTH = 3;
            f32x4 tc[8][2], ts[8][2];
#define EPJ_LOAD(g_) do { const int pos_ = (row0 + ((g_) >> 2) * HALF + ((g_) & 3) * 16) & 4095; const float* cp_ = cosR + (size_t)pos_ * 128 + cl; const float* sp_ = sinR + (size_t)pos_ * 128 + cl; \
                tc[g_][0] = *(const f32x4*)cp_; tc[g_][1] = *(const f32x4*)(cp_ + 4); ts[g_][0] = *(const f32x4*)sp_; ts[g_][1] = *(const f32x4*)(sp_ + 4); } while (0)
#pragma unroll
            for (int g = 0; g < DEPTH; ++g) EPJ_LOAD(g);
#pragma unroll
            for (int g = 0; g < 8; ++g) { const int ai = g >> 2, m = g & 3, row = row0 + ai * HALF + m * 16;
                f32x4 o1[2], o2[2];
#pragma unroll
                for (int n = 0; n < 2; ++n) { const f32x4 c = tc[g][n] * sc, s = ts[g][n] * sc; const f32x4 x1 = acc[ai][0][m][n], x2 = acc[ai][1][m][n];
                    o1[n] = x1 * c - x2 * s; o2[n] = x2 * c + x1 * s; }
                bf16_t* rowp = P + (size_t)row * ldp + pn * BM + cl;
                *(u32x4*)(rowp) = pack8(o1[0], o1[1]); *(u32x4*)(rowp + HALF) = pack8(o2[0], o2[1]); asm volatile("" ::: "memory");
                if (g + DEPTH < 8) EPJ_LOAD(g + DEPTH); }
#undef EPJ_LOAD
        } else {
#pragma unroll
            for (int ai = 0; ai < 2; ++ai)
#pragma unroll
                for (int m = 0; m < 4; ++m) { const int row = row0 + ai * HALF + m * 16; bf16_t* rowp = P + (size_t)row * ldp + pn * BM + cl;
                    *(u32x4*)(rowp) = pack8(acc[ai][0][m][0], acc[ai][0][m][1]); *(u32x4*)(rowp + HALF) = pack8(acc[ai][1][m][0], acc[ai][1][m][1]); }
        }
    }
};
__device__ __forceinline__ u32x4 pair16(const u32x2 a, const u32x2 b) {
    auto rx = __builtin_amdgcn_permlane16_swap(a.x, b.x, false, false); auto ry = __builtin_amdgcn_permlane16_swap(a.y, b.y, false, false);
    u32x4 w; w.x = rx[0]; w.y = ry[0]; w.z = rx[1]; w.w = ry[1]; return w; }
struct EpiC8 {
    static constexpr bool PERM = true, AFTER_DRAIN = false;
    unsigned char* C8; unsigned char* krope; float* ssq_cq; float* ssq_ckv; const float* cosM; const float* sinM;
    __device__ __forceinline__ void operator()(const f32x4 (&acc_)[2][2][4][2], const Unit& u, int wr, int wc, int fr, int fq) const {
        const int row0 = u.pm * BM + wr * 64 + fr, cl = wc * 32 + 8 * fq, pn = u.pn; constexpr float inv = 1.0f / W8_SCALE;
        if (pn < 6) {
            float* ssq = pn >= 4 ? ssq_ckv : ssq_cq;
            u32x2 c8p[2] = {};
#pragma unroll
            for (int ai = 0; ai < 2; ++ai)
#pragma unroll
                for (int m = 0; m < 4; ++m) { const int row = row0 + ai * HALF + m * 16; const f32x4 a00 = acc_[ai][0][m][0] * inv, a01 = acc_[ai][0][m][1] * inv, a10 = acc_[ai][1][m][0] * inv, a11 = acc_[ai][1][m][1] * inv;
                    const u32x2 c0 = pack8_fp8(a00, a01), c1 = pack8_fp8(a10, a11);
                    if ((m & 1) == 0) { c8p[0] = c0; c8p[1] = c1; }
                    else { unsigned char* c8 = C8 + (size_t)(row - 16 + 16 * (fq & 1)) * 1536 + pn * BM + cl - 8 * (fq & 1); *(u32x4*)c8 = pair16(c8p[0], c0); *(u32x4*)(c8 + HALF) = pair16(c8p[1], c1); }
                    float s = (sumsq4(a00) + sumsq4(a01)) + (sumsq4(a10) + sumsq4(a11)); s = quad_row_sum(s);
                    if (fq == 0) atomic_add_f32(ssq + row, s); }
        } else if (wc == 0) {
            f32x4 acc[2][2][4][2]; u32x2 krp[2] = {};
#pragma unroll
            for (int ai = 0; ai < 2; ++ai)
#pragma unroll
                for (int bj = 0; bj < 2; ++bj)
#pragma unroll
                    for (int m = 0; m < 4; ++m) { acc[ai][bj][m][0] = acc_[ai][bj][m][0] * inv; acc[ai][bj][m][1] = acc_[ai][bj][m][1] * inv; }

#pragma unroll
            for (int ai = 0; ai < 2; ++ai)
#pragma unroll
                for (int m = 0; m < 4; ++m) { const int row = row0 + ai * HALF + m * 16, pos = row & 4095;
                    const float* cp = cosM + (size_t)pos * 32 + 8 * fq; const float* sp = sinM + (size_t)pos * 32 + 8 * fq;
                    f32x4 o1[2], o2[2];
#pragma unroll
                    for (int n = 0; n < 2; ++n) { const f32x4 c = *(const f32x4*)(cp + 4 * n), s = *(const f32x4*)(sp + 4 * n); const f32x4 x1 = acc[ai][0][m][n], x2 = acc[ai][1][m][n];
                        o1[n] = x1 * c - x2 * s; o2[n] = x2 * c + x1 * s; }
                    unsigned char* rowp = krope + (size_t)row * 64 + 8 * fq;
                    const u32x2 r1 = pack8_fp8(o1[0], o1[1]), r2 = pack8_fp8(o2[0], o2[1]);
                    if ((m & 1) == 0) { krp[0] = r1; krp[1] = r2; }
                    else { unsigned char* rp2 = krope + (size_t)(row - 16 + 16 * (fq & 1)) * 64 + 8 * fq - 8 * (fq & 1); *(u32x4*)rp2 = pair16(krp[0], r1); *(u32x4*)(rp2 + 32) = pair16(krp[1], r2); }
                    asm volatile("" ::: "memory"); }
        }
    }
};

struct EpiQ {
    static constexpr bool PERM = true, AFTER_DRAIN = false;
    unsigned char* Q; const float* ssq; const float* cosM; const float* sinM;
    __device__ __forceinline__ void operator()(const f32x4 (&acc)[2][2][4][2], const Unit& u, int wr, int wc, int fr, int fq) const {
        const int row0 = u.pm * BM + wr * 64 + fr, cl = wc * 32 + 8 * fq, pn = u.pn;
        float sqv[8];
#pragma unroll
        for (int g = 0; g < 8; ++g) sqv[g] = ssq[row0 + (g >> 2) * HALF + (g & 3) * 16];
        u32x2 qrp[2] = {};
        if (pn < 8) {
            const int odd = fq & 1;
#pragma unroll
            for (int ai = 0; ai < 2; ++ai)
#pragma unroll
                for (int mp = 0; mp < 2; ++mp) { const int m0 = 2 * mp, m1 = 2 * mp + 1;
                    const float rs0 = (1.0f / WQ8_SCALE) * __builtin_amdgcn_rsqf(sqv[ai * 4 + m0] * (1.0f / 1024.0f) + RMS_EPS), rs1 = (1.0f / WQ8_SCALE) * __builtin_amdgcn_rsqf(sqv[ai * 4 + m1] * (1.0f / 1024.0f) + RMS_EPS);
                    unsigned char* rowp = Q + (size_t)(row0 + ai * HALF + (m0 + odd) * 16) * 3072 + cl - 8 * odd;
#pragma unroll
                    for (int bj = 0; bj < 2; ++bj) *(u32x4*)(rowp + 192 * (2 * pn + bj)) = pair16(pack8_fp8(acc[ai][bj][m0][0] * rs0, acc[ai][bj][m0][1] * rs0), pack8_fp8(acc[ai][bj][m1][0] * rs1, acc[ai][bj][m1][1] * rs1));
                    asm volatile("" ::: "memory"); }
            return; }
#pragma unroll
        for (int ai = 0; ai < 2; ++ai)
#pragma unroll
            for (int m = 0; m < 4; ++m) { const int row = row0 + ai * HALF + m * 16; const float rs = (1.0f / WQ8_SCALE) * __builtin_amdgcn_rsqf(sqv[ai * 4 + m] * (1.0f / 1024.0f) + RMS_EPS);
                unsigned char* rowp = Q + (size_t)row * 3072;
                if (pn < 8) {
#pragma unroll
                    for (int bj = 0; bj < 2; ++bj) *(u32x2*)(rowp + 192 * (2 * pn + bj) + cl) = pack8_fp8(acc[ai][bj][m][0] * rs, acc[ai][bj][m][1] * rs);
                } else { const int pos = row & 4095, head = 4 * (pn - 8) + wc;
                    const float* cp = cosM + (size_t)pos * 32 + 8 * fq; const float* sp = sinM + (size_t)pos * 32 + 8 * fq;
                    f32x4 o1[2], o2[2];
#pragma unroll
                    for (int n = 0; n < 2; ++n) { const f32x4 c = *(const f32x4*)(cp + 4 * n) * rs, s = *(const f32x4*)(sp + 4 * n) * rs; const f32x4 x1 = acc[ai][0][m][n], x2 = acc[ai][1][m][n];
                        o1[n] = x1 * c - x2 * s; o2[n] = x2 * c + x1 * s; }
                    const u32x2 r1 = pack8_fp8(o1[0], o1[1]), r2 = pack8_fp8(o2[0], o2[1]);
                    if ((m & 1) == 0) { qrp[0] = r1; qrp[1] = r2; }
                    else { unsigned char* rp2 = Q + (size_t)(row - 16 + 16 * (fq & 1)) * 3072 + 192 * head + 128 + 8 * fq - 8 * (fq & 1); *(u32x4*)rp2 = pair16(qrp[0], r1); *(u32x4*)(rp2 + 32) = pair16(qrp[1], r2); } }
                asm volatile("" ::: "memory"); }
    }
};

struct EpiKV {
    static constexpr bool PERM = true, AFTER_DRAIN = false;
    unsigned char* K8; unsigned char* VT8; const float* ssq;
    static __device__ __forceinline__ unsigned quad_xpose(unsigned x, unsigned sel1, unsigned sel2) {
        const unsigned p1 = (unsigned)__builtin_amdgcn_update_dpp(0, (int)x, 0xB1, 0xf, 0xf, true);
        const unsigned y = __builtin_amdgcn_perm(p1, x, sel1);
        const unsigned p2 = (unsigned)__builtin_amdgcn_update_dpp(0, (int)y, 0x4E, 0xf, 0xf, true);
        return __builtin_amdgcn_perm(p2, y, sel2); }
    __device__ __forceinline__ void operator()(const f32x4 (&acc)[2][2][4][2], const Unit& u, int wr, int wc, int fr, int fq) const {
        const int row0 = u.pm * BM + wr * 64 + fr, cl = wc * 32 + 8 * fq, pn = u.pn;
        float sqv[8];
#pragma unroll
        for (int g = 0; g < 8; ++g) sqv[g] = ssq[row0 + (g >> 2) * HALF + (g & 3) * 16];
        const unsigned sel1 = (fr & 1) ? 0x03070105u : 0x06020400u, sel2 = (fr & 2) ? 0x03020706u : 0x05040100u;
        const bool up = (fr & 8) != 0;
        const int rowb = u.pm * BM + wr * 64;
        unsigned char* vbase16 = VT8 + ((size_t)(((rowb >> 12) * 16 + pn) * 128 + cl + (fr & 3)) << 12) + (rowb & 4095) + 32 * ((fr >> 2) & 1) + 16 * (fr >> 3);
#pragma unroll
        for (int ai = 0; ai < 2; ++ai) { u32x2 oxm[2], oym[2];
#pragma unroll
            for (int m1 = 0; m1 < 2; ++m1) { unsigned dx[2], dy[2]; u32x2 kq[2];
#pragma unroll
                for (int m0 = 0; m0 < 2; ++m0) { const int m = 2 * m1 + m0, row = row0 + ai * HALF + m * 16; const float rs = (1.0f / WQ8_SCALE) * __builtin_amdgcn_rsqf(sqv[ai * 4 + m] * (1.0f / 512.0f) + RMS_EPS);
                    kq[m0] = pack8_fp8(acc[ai][0][m][0] * rs, acc[ai][0][m][1] * rs);
                    const u32x2 vw = pack8_fp8(acc[ai][1][m][0] * rs, acc[ai][1][m][1] * rs);
                    dx[m0] = quad_xpose(vw.x, sel1, sel2); dy[m0] = quad_xpose(vw.y, sel1, sel2); }
                const unsigned rx = (unsigned)__builtin_amdgcn_update_dpp(0, (int)(up ? dx[0] : dx[1]), 0x128, 0xf, 0xf, true);
                const unsigned ry = (unsigned)__builtin_amdgcn_update_dpp(0, (int)(up ? dy[0] : dy[1]), 0x128, 0xf, 0xf, true);
                u32x2 ox, oy; ox.x = up ? rx : dx[0]; ox.y = up ? dx[1] : rx; oy.x = up ? ry : dy[0]; oy.y = up ? dy[1] : ry;
                *(u32x4*)(K8 + (size_t)(row0 + ai * HALF + (2 * m1 + (fq & 1)) * 16) * 2048 + 128 * pn + cl - 8 * (fq & 1)) = pair16(kq[0], kq[1]);
                oxm[m1] = ox; oym[m1] = oy; }
            { const u32x2 sx = up ? oxm[0] : oxm[1], sy = up ? oym[0] : oym[1]; u32x2 gx, gy;
              gx.x = (unsigned)__builtin_amdgcn_update_dpp(0, (int)sx.x, 0x128, 0xf, 0xf, true); gx.y = (unsigned)__builtin_amdgcn_update_dpp(0, (int)sx.y, 0x128, 0xf, 0xf, true);
              gy.x = (unsigned)__builtin_amdgcn_update_dpp(0, (int)sy.x, 0x128, 0xf, 0xf, true); gy.y = (unsigned)__builtin_amdgcn_update_dpp(0, (int)sy.y, 0x128, 0xf, 0xf, true);
              u32x4 wx, wy;
              if (up) { wx.x = gx.x; wx.y = gx.y; wx.z = oxm[1].x; wx.w = oxm[1].y; wy.x = gy.x; wy.y = gy.y; wy.z = oym[1].x; wy.w = oym[1].y; }
              else    { wx.x = oxm[0].x; wx.y = oxm[0].y; wx.z = gx.x; wx.w = gx.y; wy.x = oym[0].x; wy.y = oym[0].y; wy.z = gy.x; wy.w = gy.y; }
              unsigned char* vp = vbase16 + ai * HALF;
              *(u32x4*)vp = wx; *(u32x4*)(vp + ((size_t)4 << 12)) = wy; } }
    }
};

template <bool BASE_BF16, int DEPTH = 4> struct EpiResT {
    static constexpr bool PERM = true, AFTER_DRAIN = false;
    const float* basef; bf16_t* HB; float* ssq; unsigned char* H8;
    __device__ __forceinline__ void operator()(const f32x4 (&acc)[2][2][4][2], const Unit& u, int wr, int wc, int fr, int fq) const {
        const int row0 = u.pm * BM + wr * 64 + fr, col0 = u.pn * BM + wc * 32 + 8 * fq;
        f32x4 b[8][4]; u32x4 bh[8][2]; u32x2 h8p[2] = {};
#define ER_LOAD(g_) do { const size_t off_ = (size_t)(row0 + ((g_) >> 2) * HALF + ((g_) & 3) * 16) * 4096 + col0; \
            if constexpr (BASE_BF16) { bh[g_][0] = *(const u32x4*)(HB + off_); bh[g_][1] = *(const u32x4*)(HB + off_ + HALF); } \
            else { b[g_][0] = *(const f32x4*)(basef + off_); b[g_][1] = *(const f32x4*)(basef + off_ + 4); b[g_][2] = *(const f32x4*)(basef + off_ + HALF); b[g_][3] = *(const f32x4*)(basef + off_ + HALF + 4); } } while (0)
#pragma unroll
        for (int g = 0; g < DEPTH; ++g) ER_LOAD(g);
#pragma unroll
        for (int g = 0; g < 8; ++g) { const int ai = g >> 2, m = g & 3, row = row0 + ai * HALF + m * 16; const size_t off = (size_t)row * 4096 + col0; float s = 0.f;
#pragma unroll
            for (int bj = 0; bj < 2; ++bj) { f32x4 b0, b1;
                if constexpr (BASE_BF16) { const u32x4 w = bh[g][bj]; b0 = (f32x4){bf_lo(w.x), bf_hi(w.x), bf_lo(w.y), bf_hi(w.y)}; b1 = (f32x4){bf_lo(w.z), bf_hi(w.z), bf_lo(w.w), bf_hi(w.w)}; }
                else { b0 = b[g][2 * bj]; b1 = b[g][2 * bj + 1]; }
                const f32x4 v0 = acc[ai][bj][m][0] + b0, v1 = acc[ai][bj][m][1] + b1;
                *(u32x4*)(HB + off + bj * HALF) = pack8(v0, v1);
                if (H8) { const u32x2 h8c = pack8_fp8(v0, v1);
                    if ((g & 1) == 0) h8p[bj] = h8c;
                    else *(u32x4*)(H8 + (size_t)(row - 16 + 16 * (fq & 1)) * 4096 + col0 - 8 * (fq & 1) + bj * HALF) = pair16(h8p[bj], h8c); }
                s += sumsq4(v0) + sumsq4(v1); }
            s = quad_row_sum(s); if (fq == 0) atomic_add_f32(ssq + row, s); asm volatile("" ::: "memory");
            if (g + DEPTH < 8) ER_LOAD(g + DEPTH); }
#undef ER_LOAD
    }
};


struct EpiPle {
    static constexpr bool PERM = true, AFTER_DRAIN = false;
    float* out; const bf16_t* HB; const bf16_t* PP; const float* ssq_in; float* ssq_out;
    __device__ __forceinline__ void operator()(const f32x4 (&acc)[2][2][4][2], const Unit& u, int wr, int wc, int fr, int fq) const {
        const int row0 = u.pm * BM + wr * 64 + fr, col0 = u.pn * BM + wc * 32 + 8 * fq;
#pragma unroll
        for (int ai = 0; ai < 2; ++ai)
#pragma unroll
            for (int m = 0; m < 4; ++m) { const int row = row0 + ai * HALF + m * 16; const size_t off = (size_t)row * 4096 + col0; float s = 0.f;
                const float nrs = (-1.4426950408889634f / W8_SCALE) * __builtin_amdgcn_rsqf(ssq_in[row] * (1.0f / 4096.0f) + RMS_EPS);
#pragma unroll
                for (int bj = 0; bj < 2; ++bj) { const u32x4 hw = *(const u32x4*)(HB + off + bj * HALF); const f32x4 b0 = (f32x4){bf_lo(hw.x), bf_hi(hw.x), bf_lo(hw.y), bf_hi(hw.y)}, b1 = (f32x4){bf_lo(hw.z), bf_hi(hw.z), bf_lo(hw.w), bf_hi(hw.w)}; const u32x4 pw = *(const u32x4*)(PP + off + bj * HALF);
                    f32x4 g0, g1;
#pragma unroll
                    for (int i = 0; i < 4; ++i) { g0[i] = __builtin_amdgcn_rcpf(1.0f + __builtin_amdgcn_exp2f(acc[ai][bj][m][0][i] * nrs)); g1[i] = __builtin_amdgcn_rcpf(1.0f + __builtin_amdgcn_exp2f(acc[ai][bj][m][1][i] * nrs)); }
                    const f32x4 p0 = (f32x4){bf_lo(pw.x), bf_hi(pw.x), bf_lo(pw.y), bf_hi(pw.y)}, p1 = (f32x4){bf_lo(pw.z), bf_hi(pw.z), bf_lo(pw.w), bf_hi(pw.w)};
                    const f32x4 v0 = b0 + g0 * p0, v1 = b1 + g1 * p1;
                    *(f32x4*)(out + off + bj * HALF) = v0; *(f32x4*)(out + off + bj * HALF + 4) = v1; s += sumsq4(v0) + sumsq4(v1); }
                s = quad_row_sum(s); if (fq == 0) atomic_add_f32(ssq_out + row, s); asm volatile("" ::: "memory"); }
    }
};

__device__ __forceinline__ float dpp_shr1z(float src) { return __int_as_float(__builtin_amdgcn_update_dpp(0, __float_as_int(src), 0x111, 0xf, 0xf, true)); }
__device__ __forceinline__ float dpp_shr2z(float src) { return __int_as_float(__builtin_amdgcn_update_dpp(0, __float_as_int(src), 0x112, 0xf, 0xf, true)); }
__device__ __forceinline__ float dpp_ror1(float src) { return __int_as_float(__builtin_amdgcn_update_dpp(0, __float_as_int(src), 0x121, 0xf, 0xf, true)); }
__device__ __forceinline__ float dpp_ror2(float src) { return __int_as_float(__builtin_amdgcn_update_dpp(0, __float_as_int(src), 0x122, 0xf, 0xf, true)); }
struct EpiGU {
    static constexpr bool PERM = true, AFTER_DRAIN = false;
    bf16_t* ACT; const float* ssq; const float* cw; const float* cb; float* GT; float* GH; float* UH;
    __device__ __forceinline__ void operator()(const f32x4 (&acc)[2][2][4][2], const Unit& u, int wr, int wc, int fr, int fq) const {
        const int row0 = u.pm * BM + wr * 64 + fr, f0 = u.pn * HALF + wc * 32 + 8 * fq;
        float sqv[8];
#pragma unroll
        for (int g = 0; g < 8; ++g) sqv[g] = ssq[row0 + (g >> 2) * HALF + (g & 3) * 16];
        f32x4 w0[2], w1[2], w2[2], bb[2], w0m[2], w1m[2];
#pragma unroll
        for (int n = 0; n < 2; ++n) { w0[n] = *(const f32x4*)(cw + f0 + 4 * n); w1[n] = *(const f32x4*)(cw + 11008 + f0 + 4 * n); w2[n] = *(const f32x4*)(cw + 22016 + f0 + 4 * n); bb[n] = *(const f32x4*)(cb + f0 + 4 * n);
            w1m[n] = (fr == 0) ? w1[n] : (f32x4){0.f, 0.f, 0.f, 0.f}; w0m[n] = (fr < 2) ? w0[n] : (f32x4){0.f, 0.f, 0.f, 0.f}; }
#pragma unroll
        for (int ai = 0; ai < 2; ++ai) {
            const int grp = (u.pm * BM + ai * HALF + wr * 64) >> 6;
            f32x4 pg[2] = {(f32x4){0.f, 0.f, 0.f, 0.f}, (f32x4){0.f, 0.f, 0.f, 0.f}};
#pragma unroll
            for (int m = 0; m < 4; ++m) { const int row = row0 + ai * HALF + m * 16; const float rs = __builtin_amdgcn_rsqf(sqv[ai * 4 + m] * (1.0f / 4096.0f) + RMS_EPS);
                f32x4 av[2];
#pragma unroll
                for (int n = 0; n < 2; ++n) { const f32x4 G = acc[ai][0][m][n] * rs, U = acc[ai][1][m][n] * rs; f32x4 r;
#pragma unroll
                    for (int i = 0; i < 4; ++i) { float a = bb[n][i] + w2[n][i] * G[i]; a += w1[n][i] * dpp_shr1z(G[i]); a += w0[n][i] * dpp_shr2z(G[i]);
                        if (m > 0) { a += w1m[n][i] * dpp_ror1(pg[n][i]); a += w0m[n][i] * dpp_ror2(pg[n][i]); }
                        r[i] = a * __builtin_amdgcn_rcpf(1.0f + __builtin_amdgcn_exp2f(-1.4426950408889634f * a)) * U[i]; }
                    av[n] = r; pg[n] = G;
                    if (m == 0 && fr < 2) { *(f32x4*)(GH + ((size_t)grp * 2 + fr) * 11008 + f0 + 4 * n) = G; *(f32x4*)(UH + ((size_t)grp * 2 + fr) * 11008 + f0 + 4 * n) = U; }
                    if (m == 3 && fr >= 14) *(f32x4*)(GT + ((size_t)grp * 2 + (fr - 14)) * 11008 + f0 + 4 * n) = G; }
                *(u32x4*)(ACT + (size_t)row * 11008 + f0) = pack8(av[0], av[1]); }
        }
    }
};

struct PanelOrder {
    int c;
    __device__ __forceinline__ bool next(int i, Unit& u) const { if (i >= 4) return false; const int x = c & 7, j = c >> 3; u.pm = 16 * i + 2 * x + (j >> 4); u.pn = j & 15; return true; }
    __device__ __forceinline__ void a_ready(const Unit&) const {}
    __device__ __forceinline__ void done(const Unit&) const {}
};
struct EpiPleFinal {
    static constexpr bool PERM = true, AFTER_DRAIN = false;
    float* out; const bf16_t* HB; const bf16_t* PP; const float* ssq_in; float* ssq3; unsigned* cnt; const float* gfin;
    __device__ __forceinline__ void operator()(const f32x4 (&acc)[2][2][4][2], const Unit& u, int wr, int wc, int fr, int fq) const {
        const int row0 = u.pm * BM + wr * 64 + fr, col0 = u.pn * BM + wc * 32 + 8 * fq;
        f32x4 h[2][2][4][2];
        constexpr int DEPTH = 4;
        u32x4 bh[8][2]; u32x4 pq[8][2]; float sq[8];
#define EP_LOAD(g_) do { const int row_ = row0 + ((g_) >> 2) * HALF + ((g_) & 3) * 16; const size_t off_ = (size_t)row_ * 4096 + col0; sq[g_] = ssq_in[row_]; \
            bh[g_][0] = *(const u32x4*)(HB + off_); bh[g_][1] = *(const u32x4*)(HB + off_ + HALF); \
            pq[g_][0] = *(const u32x4*)(PP + off_); pq[g_][1] = *(const u32x4*)(PP + off_ + HALF); } while (0)
#pragma unroll
        for (int g = 0; g < DEPTH; ++g) EP_LOAD(g);
#pragma unroll
        for (int g = 0; g < 8; ++g) { const int ai = g >> 2, m = g & 3, row = row0 + ai * HALF + m * 16; float s = 0.f;
            const float nrs = (-1.4426950408889634f / W8_SCALE) * __builtin_amdgcn_rsqf(sq[g] * (1.0f / 4096.0f) + RMS_EPS);
#pragma unroll
            for (int bj = 0; bj < 2; ++bj) { const u32x4 pw = pq[g][bj];
                f32x4 g0, g1;
#pragma unroll
                for (int i = 0; i < 4; ++i) { g0[i] = __builtin_amdgcn_rcpf(1.0f + __builtin_amdgcn_exp2f(acc[ai][bj][m][0][i] * nrs)); g1[i] = __builtin_amdgcn_rcpf(1.0f + __builtin_amdgcn_exp2f(acc[ai][bj][m][1][i] * nrs)); }
                const f32x4 p0 = (f32x4){bf_lo(pw.x), bf_hi(pw.x), bf_lo(pw.y), bf_hi(pw.y)}, p1 = (f32x4){bf_lo(pw.z), bf_hi(pw.z), bf_lo(pw.w), bf_hi(pw.w)};
                const u32x4 hw = bh[g][bj]; const f32x4 b0 = (f32x4){bf_lo(hw.x), bf_hi(hw.x), bf_lo(hw.y), bf_hi(hw.y)}, b1 = (f32x4){bf_lo(hw.z), bf_hi(hw.z), bf_lo(hw.w), bf_hi(hw.w)};
                const f32x4 v0 = b0 + g0 * p0, v1 = b1 + g1 * p1;
                h[ai][bj][m][0] = v0; h[ai][bj][m][1] = v1; s += sumsq4(v0) + sumsq4(v1); }
            s = quad_row_sum(s); if (fq == 0) atomic_add_f32(ssq3 + row, s); asm volatile("" ::: "memory");
            if (g + DEPTH < 8) EP_LOAD(g + DEPTH); }
#undef EP_LOAD
        asm volatile("s_waitcnt vmcnt(0)" ::: "memory");
        unsigned* cw = cnt + 64 * u.pm;
        if ((threadIdx.x & 63) == 0) __hip_atomic_fetch_add(cw, 1u, __ATOMIC_RELAXED, __HIP_MEMORY_SCOPE_AGENT);
        if (threadIdx.x < 64) { unsigned spins = 0;
            while ((unsigned)__builtin_amdgcn_readfirstlane(__hip_atomic_load(cw, __ATOMIC_RELAXED, __HIP_MEMORY_SCOPE_AGENT)) < 128u) { __builtin_amdgcn_s_sleep(2); if (++spins > (1u << 22)) break; }
            asm volatile("s_waitcnt vmcnt(0)" ::: "memory"); }
        asm volatile("" ::: "memory"); __builtin_amdgcn_s_barrier(); asm volatile("" ::: "memory");
        float s3[8]; f32x4 gf[2][2];
#pragma unroll
        for (int g = 0; g < 8; ++g) s3[g] = __hip_atomic_load(ssq3 + row0 + (g >> 2) * HALF + (g & 3) * 16, __ATOMIC_RELAXED, __HIP_MEMORY_SCOPE_AGENT);
#pragma unroll
        for (int bj = 0; bj < 2; ++bj) { gf[bj][0] = *(const f32x4*)(gfin + col0 + bj * HALF); gf[bj][1] = *(const f32x4*)(gfin + col0 + bj * HALF + 4); }
#pragma unroll
        for (int ai = 0; ai < 2; ++ai)
#pragma unroll
            for (int m = 0; m < 4; ++m) { const int row = row0 + ai * HALF + m * 16; const size_t off = (size_t)row * 4096 + col0;
                const float rs = __builtin_amdgcn_rsqf(s3[ai * 4 + m] * (1.0f / 4096.0f) + RMS_EPS);
#pragma unroll
                for (int bj = 0; bj < 2; ++bj) { *(f32x4*)(out + off + bj * HALF) = h[ai][bj][m][0] * (gf[bj][0] * rs); *(f32x4*)(out + off + bj * HALF + 4) = h[ai][bj][m][1] * (gf[bj][1] * rs); } }
    }
};
template <class Epi, class Sched, bool ALIGN_EPI = false, bool SP2 = false>
__device__ __forceinline__ void gemm_phase(PG8_LAS unsigned char* lds, const Gemm g, const Sched& S, const Epi& E) {
    const int tid = threadIdx.x, wid = __builtin_amdgcn_readfirstlane(tid >> 6), lane = tid & 63, wr = wid >> 2, wc = wid & 3, fr = lane & 15, fq = lane >> 4;
    int K = g.K; asm volatile("" : "+s"(K));
    const int nt = K / BK;
    unsigned voffA[2], voffB[2];
#pragma unroll
    for (int i = 0; i < 2; ++i) { int R, C; stage_rc(tid * 16 + i * 8192, R, C); const int Rb = Epi::PERM ? ((R & ~31) + perm32(R & 31)) : R;
        voffA[i] = (unsigned)(R * g.lda + C) * 2u; voffB[i] = (unsigned)(Rb * g.ldb + C) * 2u; }
    const size_t kstep = (size_t)(BK * 2);
    const size_t hstepA = (size_t)HALF * g.lda * 2, hstepB = (size_t)HALF * g.ldb * 2;
    const size_t tstepA = 2 * hstepA, tstepB = 2 * hstepB;
    const unsigned ldsw = (unsigned)wid * 1024u;
    const int aoff = lds_byte(wr * 64 + fr, fq * 8), boff = lds_byte(wc * 32 + fr, fq * 8);
#define PG8_SA(b, h) (((b) * 2 + (h)) * HTB)
#define PG8_SB(b, h) ((4 + (b) * 2 + (h)) * HTB)
#ifndef PG8_B_AUX
#define PG8_B_AUX 0
#endif
#define PG8_STAGE(bufoff, gbase, voff) do { _Pragma("unroll") for (int _i = 0; _i < 2; ++_i) { \
        if ((bufoff) >= 4 * HTB) __builtin_amdgcn_global_load_lds((const unsigned*)((const char*)(gbase) + (voff)[_i]), (PG8_LAS unsigned*)(lds + (bufoff) + ldsw + _i * 8192), 16, 0, PG8_B_AUX); \
        else __builtin_amdgcn_global_load_lds((const unsigned*)((const char*)(gbase) + (voff)[_i]), (PG8_LAS unsigned*)(lds + (bufoff) + ldsw + _i * 8192), 16, 0, 0); } } while (0)
#define PG8_LDA(dst, b, h) do { _Pragma("unroll") for (int m = 0; m < 4; ++m) _Pragma("unroll") for (int k = 0; k < 2; ++k) dst[m][k] = *(const PG8_LAS bf16x8*)(lds + PG8_SA(b, h) + aoff + m * 2048 + k * 1024); } while (0)
#define PG8_LDB(dst, b, h) do { _Pragma("unroll") for (int n = 0; n < 2; ++n) _Pragma("unroll") for (int k = 0; k < 2; ++k) dst[n][k] = *(const PG8_LAS bf16x8*)(lds + PG8_SB(b, h) + boff + n * 2048 + k * 1024); } while (0)
#define PG8_MMA(ai, bj, At, Bt) do { __builtin_amdgcn_s_setprio(1); _Pragma("unroll") for (int m = 0; m < 4; ++m) _Pragma("unroll") for (int n = 0; n < 2; ++n) _Pragma("unroll") for (int k = 0; k < 2; ++k) \
        acc[ai][bj][m][n] = __builtin_amdgcn_mfma_f32_16x16x32_bf16(Bt[n][k], At[m][k], acc[ai][bj][m][n], 0, 0, 0); __builtin_amdgcn_s_setprio(0); } while (0)
#define PG8_WAIT_V(n) asm volatile("s_waitcnt vmcnt(" #n ")" ::: "memory")
#define PG8_WAIT_L(n) asm volatile("s_waitcnt lgkmcnt(" #n ")" ::: "memory")
#define PG8_BAR __builtin_amdgcn_s_barrier()
#define PG8_SCHED __builtin_amdgcn_sched_barrier(0)
    Unit cur, nxt; int ui = 0;
    if (!S.next(0, cur)) return;
    f32x4 acc[2][2][4][2];
#pragma unroll
    for (int a = 0; a < 2; ++a)
#pragma unroll
        for (int b = 0; b < 2; ++b)
#pragma unroll
            for (int m = 0; m < 4; ++m)
#pragma unroll
                for (int n = 0; n < 2; ++n) acc[a][b][m][n] = (f32x4){0.f, 0.f, 0.f, 0.f};
    bf16x8 At[4][2], B0[2][2], B1[2][2];
    const char* cA = (const char*)g.A + (size_t)cur.pm * tstepA; const char* cB = (const char*)g.Bt + (size_t)cur.pn * tstepB;
    S.a_ready(cur);
    if constexpr (SP2) {
        PG8_STAGE(PG8_SB(0, 0), cB, voffB); PG8_STAGE(PG8_SB(0, 1), cB + hstepB, voffB); PG8_STAGE(PG8_SA(0, 0), cA, voffA); PG8_STAGE(PG8_SA(0, 1), cA + hstepA, voffA);
        if (wr == 1) PG8_BAR;
        PG8_WAIT_V(2); PG8_BAR;
        PG8_STAGE(PG8_SB(1, 0), cB + kstep, voffB); PG8_STAGE(PG8_SA(1, 0), cA + kstep, voffA); PG8_STAGE(PG8_SB(1, 1), cB + hstepB + kstep, voffB);
        PG8_WAIT_V(6); PG8_BAR;
    } else {
        PG8_STAGE(PG8_SB(0, 0), cB, voffB); PG8_STAGE(PG8_SA(0, 0), cA, voffA); PG8_STAGE(PG8_SB(0, 1), cB + hstepB, voffB); PG8_STAGE(PG8_SA(0, 1), cA + hstepA, voffA);
        if (wr == 1) PG8_BAR;
        PG8_WAIT_V(4); PG8_BAR;
        PG8_STAGE(PG8_SB(1, 0), cB + kstep, voffB); PG8_STAGE(PG8_SA(1, 0), cA + kstep, voffA); PG8_STAGE(PG8_SB(1, 1), cB + hstepB + kstep, voffB);
        PG8_WAIT_V(6); PG8_BAR;
    }
    for (;;) {
        const bool has_next = S.next(ui + 1, nxt);
        const char* nA = has_next ? (const char*)g.A + (size_t)nxt.pm * tstepA : cA; const char* nB = has_next ? (const char*)g.Bt + (size_t)nxt.pn * tstepB : cB;
        for (int t = 0; t < nt; t += 2) {
            const bool last = (t == nt - 2);
            const char* a1 = cA + (size_t)(t + 1) * kstep;
            const char* a2 = last ? nA : cA + (size_t)(t + 2) * kstep; const char* b2 = last ? nB : cB + (size_t)(t + 2) * kstep;
            const char* a3 = a2 + kstep; const char* b3 = b2 + kstep;
            if (last && has_next) S.a_ready(nxt);
            if constexpr (SP2) {
            PG8_LDB(B0, 0, 0); PG8_LDB(B1, 0, 1); PG8_SCHED; PG8_LDA(At, 0, 0); PG8_STAGE(PG8_SA(1, 1), a1 + hstepA, voffA);
            PG8_WAIT_V(8); PG8_WAIT_L(0); PG8_BAR; PG8_MMA(0, 0, At, B0); PG8_MMA(0, 1, At, B1); PG8_BAR; PG8_SCHED;
            PG8_LDA(At, 0, 1); PG8_STAGE(PG8_SB(0, 0), b2, voffB); PG8_STAGE(PG8_SB(0, 1), b2 + hstepB, voffB); PG8_STAGE(PG8_SA(0, 0), a2, voffA);
            PG8_WAIT_V(8); PG8_WAIT_L(0); PG8_BAR; PG8_MMA(1, 0, At, B0); PG8_MMA(1, 1, At, B1); PG8_BAR; PG8_SCHED;
            PG8_LDB(B0, 1, 0); PG8_LDB(B1, 1, 1); PG8_SCHED; PG8_LDA(At, 1, 0); PG8_STAGE(PG8_SA(0, 1), a2 + hstepA, voffA);
            PG8_WAIT_V(8); PG8_WAIT_L(0); PG8_BAR; PG8_MMA(0, 0, At, B0); PG8_MMA(0, 1, At, B1); PG8_BAR; PG8_SCHED;
            PG8_LDA(At, 1, 1); PG8_STAGE(PG8_SB(1, 0), b3, voffB); PG8_STAGE(PG8_SB(1, 1), b3 + hstepB, voffB); PG8_STAGE(PG8_SA(1, 0), a3, voffA);
            PG8_WAIT_V(8); PG8_WAIT_L(0); PG8_BAR; PG8_MMA(1, 0, At, B0); PG8_MMA(1, 1, At, B1); PG8_BAR; PG8_SCHED;
            } else {
            PG8_LDB(B0, 0, 0); PG8_SCHED; PG8_LDA(At, 0, 0); PG8_STAGE(PG8_SA(1, 1), a1 + hstepA, voffA);
            PG8_WAIT_L(8); PG8_BAR; PG8_WAIT_L(0); PG8_MMA(0, 0, At, B0); PG8_BAR; PG8_SCHED;
            PG8_LDB(B1, 0, 1); PG8_STAGE(PG8_SB(0, 0), b2, voffB);
            PG8_BAR; PG8_WAIT_L(0); PG8_MMA(0, 1, At, B1); PG8_BAR;
            PG8_LDA(At, 0, 1); PG8_STAGE(PG8_SA(0, 0), a2, voffA);
            PG8_BAR; PG8_WAIT_L(0); PG8_MMA(1, 0, At, B0); PG8_BAR; PG8_SCHED;
            PG8_STAGE(PG8_SB(0, 1), b2 + hstepB, voffB);
            PG8_WAIT_V(6); PG8_BAR; PG8_MMA(1, 1, At, B1); PG8_BAR;
            PG8_LDB(B0, 1, 0); PG8_SCHED; PG8_LDA(At, 1, 0); PG8_STAGE(PG8_SA(0, 1), a2 + hstepA, voffA);
            PG8_WAIT_L(8); PG8_BAR; PG8_WAIT_L(0); PG8_MMA(0, 0, At, B0); PG8_BAR; PG8_SCHED;
            PG8_LDB(B1, 1, 1); PG8_STAGE(PG8_SB(1, 0), b3, voffB);
            PG8_BAR; PG8_WAIT_L(0); PG8_MMA(0, 1, At, B1); PG8_BAR;
            PG8_LDA(At, 1, 1); PG8_STAGE(PG8_SA(1, 0), a3, voffA);
            PG8_BAR; PG8_WAIT_L(0); PG8_MMA(1, 0, At, B0); PG8_BAR; PG8_SCHED;
            PG8_STAGE(PG8_SB(1, 1), b3 + hstepB, voffB);
            PG8_WAIT_V(6); PG8_BAR; PG8_MMA(1, 1, At, B1); PG8_BAR;
            }
        }
        if constexpr (ALIGN_EPI) { if (wr == 0) PG8_BAR; }
        if constexpr (!Epi::AFTER_DRAIN) { E(acc, cur, wr, wc, fr, fq); S.done(cur); }
        if (!has_next) break;
#pragma unroll
        for (int a = 0; a < 2; ++a)
#pragma unroll
            for (int b = 0; b < 2; ++b)
#pragma unroll
                for (int m = 0; m < 4; ++m)
#pragma unroll
                    for (int n = 0; n < 2; ++n) acc[a][b][m][n] = (f32x4){0.f, 0.f, 0.f, 0.f};
        cur = nxt; cA = nA; cB = nB; ++ui;
        if constexpr (ALIGN_EPI) { if (wr == 1) PG8_BAR; }
    }
    PG8_WAIT_V(0);
    if constexpr (!ALIGN_EPI) { if (wr == 0) PG8_BAR; }
    PG8_BAR;
    if constexpr (Epi::AFTER_DRAIN) { E.fused(acc, cur, wr, wc, fr, fq, lds, wid, lane); S.done(cur); }
#undef PG8_SA
#undef PG8_SB
#undef PG8_STAGE
#undef PG8_LDA
#undef PG8_LDB
#undef PG8_MMA
#undef PG8_WAIT_V
#undef PG8_WAIT_L
#undef PG8_BAR
#undef PG8_SCHED
}
struct Gemm8 { const unsigned char* A; const unsigned char* Bt; int M, N, K, lda, ldb; };
typedef int v8i32 __attribute__((ext_vector_type(8)));
typedef int v4i32 __attribute__((ext_vector_type(4)));
template <class Epi, class Sched, bool ALIGN_EPI = true, int NTB = 0, int WSC = 0x7f7f7f7f, int ASC = 0x7f7f7f7f>
__device__ __forceinline__ void gemm_phase8(PG8_LAS unsigned char* lds, const Gemm8 g, const Sched& S, const Epi& E) {
    constexpr bool SP2 = true;
    const int tid = threadIdx.x, wid = __builtin_amdgcn_readfirstlane(tid >> 6), lane = tid & 63, wr = wid >> 2, wc = wid & 3, fr = lane & 15, fq = lane >> 4;
    int K = g.K; asm volatile("" : "+s"(K));
    const int nt = K / 128;
    unsigned voffA[2], voffB[2];
#pragma unroll
    for (int i = 0; i < 2; ++i) { int R, C; stage_rc(tid * 16 + i * 8192, R, C); const int Rb = Epi::PERM ? ((R & ~31) + perm32(R & 31)) : R;
        voffA[i] = (unsigned)(R * g.lda + 2 * C); voffB[i] = (unsigned)(Rb * g.ldb + 2 * C); }
    const size_t kstep = (size_t)(BK * 2);
    const size_t hstepA = (size_t)HALF * g.lda, hstepB = (size_t)HALF * g.ldb;
    const size_t tstepA = 2 * hstepA, tstepB = 2 * hstepB;
    const unsigned ldsw = (unsigned)wid * 1024u;
    const int aoffb = lds_byte(wr * 64 + fr, fq * 8), boffb = lds_byte(wc * 32 + fr, fq * 8);
    const int aoff0 = lds_byte(wr * 64 + fr, 16 * fq), aoff1 = lds_byte(wr * 64 + fr, 16 * fq + 8), boff0 = lds_byte(wc * 32 + fr, 16 * fq), boff1 = lds_byte(wc * 32 + fr, 16 * fq + 8);
#define PG8_SA(b, h) (((b) * 2 + (h)) * HTB)
#define PG8_SB(b, h) ((4 + (b) * 2 + (h)) * HTB)
#define PG8_STAGE(bufoff, gbase, voff) do { _Pragma("unroll") for (int _i = 0; _i < 2; ++_i) \
        __builtin_amdgcn_global_load_lds((const unsigned*)((const char*)(gbase) + (voff)[_i]), (PG8_LAS unsigned*)(lds + (bufoff) + ldsw + _i * 8192), 16, 0, 0); } while (0)
#define PG8_LDA(dst, b, h) do { const int o0_ = isb ? aoffb : aoff0, o1_ = isb ? aoffb + 1024 : aoff1; _Pragma("unroll") for (int m = 0; m < 4; ++m) { dst[m].lo = *(const PG8_LAS v4i32*)(lds + PG8_SA(b, h) + o0_ + m * 2048); dst[m].hi = *(const PG8_LAS v4i32*)(lds + PG8_SA(b, h) + o1_ + m * 2048); } } while (0)
#define PG8_LDB(dst, b, h) do { const int o0_ = isb ? boffb : boff0, o1_ = isb ? boffb + 1024 : boff1; _Pragma("unroll") for (int n = 0; n < 2; ++n) { dst[n].lo = *(const PG8_LAS v4i32*)(lds + PG8_SB(b, h) + o0_ + n * 2048); dst[n].hi = *(const PG8_LAS v4i32*)(lds + PG8_SB(b, h) + o1_ + n * 2048); } } while (0)
#define PG8_MMA(ai, bj, At, Bt) do { __builtin_amdgcn_s_setprio(1); \
        if (NTB > 0 && isb) { _Pragma("unroll") for (int m = 0; m < 4; ++m) _Pragma("unroll") for (int n = 0; n < 2; ++n) asm volatile("v_mfma_f32_16x16x32_bf16 %0, %1, %2, %0" : "+v"(acc[ai][bj][m][n]) : "v"(Bt[n].lo), "v"(At[m].lo)); \
            _Pragma("unroll") for (int m = 0; m < 4; ++m) _Pragma("unroll") for (int n = 0; n < 2; ++n) asm volatile("v_mfma_f32_16x16x32_bf16 %0, %1, %2, %0" : "+v"(acc[ai][bj][m][n]) : "v"(Bt[n].hi), "v"(At[m].hi)); } \
        else { _Pragma("unroll") for (int m = 0; m < 4; ++m) _Pragma("unroll") for (int n = 0; n < 2; ++n) \
            asm volatile("v_mfma_scale_f32_16x16x128_f8f6f4 %0, %1, %2, %0, %3, %4 op_sel_hi:[0,0,0]" : "+v"(acc[ai][bj][m][n]) : "v"(Bt[n]), "v"(At[m]), "v"(w_scale), "v"(a_scale)); } \
        __builtin_amdgcn_s_setprio(0); } while (0)
#define PG8_MFMA_DRAIN() asm volatile("s_nop 15\n\ts_nop 15\n\ts_nop 15\n\ts_nop 15\n\ts_nop 15\n\ts_nop 15" ::: "memory")
#define PG8_WAIT_V(n) asm volatile("s_waitcnt vmcnt(" #n ")" ::: "memory")
#define PG8_WAIT_L(n) asm volatile("s_waitcnt lgkmcnt(" #n ")" ::: "memory")
#define PG8_BAR __builtin_amdgcn_s_barrier()
#define PG8_SCHED __builtin_amdgcn_sched_barrier(0)
    Unit cur, nxt; int ui = 0;
    if (!S.next(0, cur)) return;
    f32x4 acc[2][2][4][2];
#pragma unroll
    for (int a = 0; a < 2; ++a)
#pragma unroll
        for (int b = 0; b < 2; ++b)
#pragma unroll
            for (int m = 0; m < 4; ++m)
#pragma unroll
                for (int n = 0; n < 2; ++n) acc[a][b][m][n] = (f32x4){0.f, 0.f, 0.f, 0.f};
    v8i32 At[4], B0[2], B1[2]; const int w_scale = WSC, a_scale = ASC;
    const char* cA = (const char*)g.A + (size_t)cur.pm * tstepA; const char* cB = (const char*)g.Bt + (size_t)cur.pn * tstepB;
    S.a_ready(cur);
    if constexpr (SP2) {
        PG8_STAGE(PG8_SB(0, 0), cB, voffB); PG8_STAGE(PG8_SB(0, 1), cB + hstepB, voffB); PG8_STAGE(PG8_SA(0, 0), cA, voffA); PG8_STAGE(PG8_SA(0, 1), cA + hstepA, voffA);
        if (wr == 1) PG8_BAR;
        PG8_WAIT_V(2); PG8_BAR;
        PG8_STAGE(PG8_SB(1, 0), cB + kstep, voffB); PG8_STAGE(PG8_SA(1, 0), cA + kstep, voffA); PG8_STAGE(PG8_SB(1, 1), cB + hstepB + kstep, voffB);
        PG8_WAIT_V(6); PG8_BAR;
    } else {
        PG8_STAGE(PG8_SB(0, 0), cB, voffB); PG8_STAGE(PG8_SA(0, 0), cA, voffA); PG8_STAGE(PG8_SB(0, 1), cB + hstepB, voffB); PG8_STAGE(PG8_SA(0, 1), cA + hstepA, voffA);
        if (wr == 1) PG8_BAR;
        PG8_WAIT_V(4); PG8_BAR;
        PG8_STAGE(PG8_SB(1, 0), cB + kstep, voffB); PG8_STAGE(PG8_SA(1, 0), cA + kstep, voffA); PG8_STAGE(PG8_SB(1, 1), cB + hstepB + kstep, voffB);
        PG8_WAIT_V(6); PG8_BAR;
    }
#define PG8_KSTEP(ISB) do { constexpr bool isb = ISB; const bool last = (t == nt - 2); \
            const char* a1 = cA + (size_t)(t + 1) * kstep; \
            const char* a2 = last ? nA : cA + (size_t)(t + 2) * kstep; const char* b2 = last ? nB : cB + (size_t)(t + 2) * kstep; \
            const char* a3 = a2 + kstep; const char* b3 = b2 + kstep; \
            if (last && has_next) S.a_ready(nxt); \
            PG8_LDB(B0, 0, 0); PG8_LDB(B1, 0, 1); PG8_SCHED; PG8_LDA(At, 0, 0); PG8_STAGE(PG8_SA(1, 1), a1 + hstepA, voffA); \
            PG8_WAIT_V(8); PG8_WAIT_L(0); PG8_BAR; PG8_MMA(0, 0, At, B0); PG8_MMA(0, 1, At, B1); PG8_BAR; PG8_SCHED; \
            PG8_LDA(At, 0, 1); PG8_STAGE(PG8_SB(0, 0), b2, voffB); PG8_STAGE(PG8_SB(0, 1), b2 + hstepB, voffB); PG8_STAGE(PG8_SA(0, 0), a2, voffA); \
            PG8_WAIT_V(8); PG8_WAIT_L(0); PG8_BAR; PG8_MMA(1, 0, At, B0); PG8_MMA(1, 1, At, B1); PG8_BAR; PG8_SCHED; \
            PG8_LDB(B0, 1, 0); PG8_LDB(B1, 1, 1); PG8_SCHED; PG8_LDA(At, 1, 0); PG8_STAGE(PG8_SA(0, 1), a2 + hstepA, voffA); \
            PG8_WAIT_V(8); PG8_WAIT_L(0); PG8_BAR; PG8_MMA(0, 0, At, B0); PG8_MMA(0, 1, At, B1); PG8_BAR; PG8_SCHED; \
            PG8_LDA(At, 1, 1); PG8_STAGE(PG8_SB(1, 0), b3, voffB); PG8_STAGE(PG8_SB(1, 1), b3 + hstepB, voffB); PG8_STAGE(PG8_SA(1, 0), a3, voffA); \
            PG8_WAIT_V(8); PG8_WAIT_L(0); PG8_BAR; PG8_MMA(1, 0, At, B0); PG8_MMA(1, 1, At, B1); PG8_BAR; PG8_SCHED; } while (0)
    for (;;) {
        const bool has_next = S.next(ui + 1, nxt);
        const char* nA = has_next ? (const char*)g.A + (size_t)nxt.pm * tstepA : cA; const char* nB = has_next ? (const char*)g.Bt + (size_t)nxt.pn * tstepB : cB;
        { int t = 0;
          if constexpr (NTB > 0) { for (; t < NTB; t += 2) PG8_KSTEP(true); }
          for (; t < nt; t += 2) PG8_KSTEP(false); }
        if constexpr (ALIGN_EPI) { if (wr == 0) PG8_BAR; }
        PG8_MFMA_DRAIN();
        if constexpr (!Epi::AFTER_DRAIN) { E(acc, cur, wr, wc, fr, fq); S.done(cur); }
        if (!has_next) break;
#pragma unroll
        for (int a = 0; a < 2; ++a)
#pragma unroll
            for (int b = 0; b < 2; ++b)
#pragma unroll
                for (int m = 0; m < 4; ++m)
#pragma unroll
                    for (int n = 0; n < 2; ++n) acc[a][b][m][n] = (f32x4){0.f, 0.f, 0.f, 0.f};
        cur = nxt; cA = nA; cB = nB; ++ui;
        if constexpr (ALIGN_EPI) { if (wr == 1) PG8_BAR; }
    }
    PG8_WAIT_V(0);
    if constexpr (!ALIGN_EPI) { if (wr == 0) PG8_BAR; }
    PG8_BAR;
    if constexpr (Epi::AFTER_DRAIN) { E.fused(acc, cur, wr, wc, fr, fq, lds, wid, lane); S.done(cur); }
#undef PG8_SA
#undef PG8_SB
#undef PG8_STAGE
#undef PG8_LDA
#undef PG8_LDB
#undef PG8_MMA
#undef PG8_KSTEP
#undef PG8_MFMA_DRAIN
#undef PG8_WAIT_V
#undef PG8_WAIT_L
#undef PG8_BAR
#undef PG8_SCHED
}
}

constexpr int NWAVES = 8;
constexpr int NB = 4, SEQ = 4096, M = NB * SEQ, DM = 4096, NFF = 11008, LDP = 9984  ;
constexpr int NGRP = M / 64;
constexpr size_t MiB = 1u << 20;
constexpr size_t WS_CTL = 0, CTL_ZERO_BYTES = 1 * MiB;
constexpr int CW_BAR = 4096;
constexpr size_t CTL_SSQ = 256 * 1024;
constexpr size_t CTL_PCNT = 64 * 1024;
constexpr size_t WS_COSM = 1 * MiB + 512 * 1024, WS_SINM = 2 * MiB, WS_COSR = 3 * MiB, WS_SINR = 5 * MiB;
constexpr size_t WS_PB = 8 * MiB;
constexpr size_t WS_KR = 16 * MiB;
constexpr size_t WS_STATS = 18 * MiB;
constexpr size_t WS_WIN = 32 * MiB, WS_WUQ = 110 * MiB, WS_WUKV = 116 * MiB, WS_WO = 120 * MiB, WS_WGU = 152 * MiB;
constexpr size_t WS_PP = 18 * MiB;
constexpr size_t WS_XB = 324 * MiB;
constexpr size_t WS_WDN = 324 * MiB, WS_WPG = 410 * MiB, WS_WPP = 1016 * MiB;
constexpr size_t WS_PROJ = 452 * MiB;
constexpr size_t WS_HB = 452 * MiB;
constexpr size_t WS_ACT = 580 * MiB;
constexpr size_t WS_Q = 764 * MiB, WS_KB = 860 * MiB, WS_VB = 924 * MiB;
constexpr size_t WS_GT = 924 * MiB, WS_GH = 946 * MiB, WS_UH = 968 * MiB;
constexpr size_t WS_H8 = 924 * MiB;
constexpr size_t WS_WIN8 = 96 * MiB;
constexpr size_t WS_XB8 = 764 * MiB;
constexpr size_t WS_C8 = 992 * MiB;
constexpr size_t WS_END = 1018 * MiB;
static_assert(WS_ACT + (size_t)M * NFF * 2 <= WS_GT && WS_UH + (size_t)NGRP * 2 * NFF * 4 <= WS_END && WS_WGU + (size_t)22016 * 4096 * 2 <= WS_XB && WS_PROJ + (size_t)M * LDP * 2 <= WS_Q, "d_ws map");

constexpr int CCP = 3072;
constexpr float MO8_SCALE = 16.0f;
constexpr int RING_BYTES = 131072, LDSCTL_OFF = RING_BYTES, MISC_OFF = LDSCTL_OFF + 320, LDS_BYTES = 147456;

#define GAS __attribute__((address_space(1)))
#define LAS __attribute__((address_space(3)))
typedef unsigned short bf16;
typedef unsigned v4u __attribute__((ext_vector_type(4)));
typedef unsigned v2u __attribute__((ext_vector_type(2)));
typedef float f32x4 __attribute__((ext_vector_type(4)));
typedef float f32x16 __attribute__((ext_vector_type(16)));
typedef short bf16x8 __attribute__((ext_vector_type(8)));
typedef short s16x4 __attribute__((ext_vector_type(4)));
typedef GAS unsigned gu32;
#define RLX_AGENT __ATOMIC_RELAXED, __HIP_MEMORY_SCOPE_AGENT
#define LDS_WAIT() asm volatile("s_waitcnt lgkmcnt(0)" ::: "memory")
#define VM_WAIT() asm volatile("s_waitcnt vmcnt(0)" ::: "memory")
#define SBAR() __builtin_amdgcn_sched_barrier(0)
__device__ __forceinline__ unsigned cvtpk(float lo, float hi) { return pg8::cvt_pk_bf16(lo, hi); }
__device__ __forceinline__ float bflo(unsigned w) { return __uint_as_float(w << 16); }
__device__ __forceinline__ float bfhi(unsigned w) { return __uint_as_float(w & 0xffff0000u); }
__device__ __forceinline__ int crow(int r, int hi) { return (r & 3) + 8 * (r >> 2) + 4 * hi; }
__device__ __forceinline__ s16x4 tr_read(const LAS unsigned char* p) { typedef short v4i16_t __attribute__((ext_vector_type(4))); return __builtin_bit_cast(s16x4, __builtin_amdgcn_ds_read_tr16_b64_v4i16((LAS v4i16_t*)p)); }
typedef __amdgpu_buffer_rsrc_t rsrc_t;
__device__ __forceinline__ rsrc_t make_rsrc(const void* p) { return __builtin_amdgcn_make_buffer_rsrc((void*)p, 0, 0x7fffffff, 0x00020000); }
__device__ __forceinline__ v4u bufld16(rsrc_t r, unsigned voff, unsigned soff) { return __builtin_bit_cast(v4u, __builtin_amdgcn_raw_buffer_load_b128(r, (int)voff, (int)soff, 0)); }
__device__ __forceinline__ void bufst16(rsrc_t r, unsigned voff, unsigned soff, v4u v) { __builtin_amdgcn_raw_buffer_store_b128(v, r, (int)voff, (int)soff, 0); }
#define XB_TMO      128
#define XB_XCNT(j)  (256  + 64 * (j))
#define XB_XSUB(j)  (1280 + 64 * (j))
#define XB_XGEN(j)  (2304 + 64 * (j))
#define XB_TOP      3328
#define XB_TOPGEN   3392
#define XCD_BAR_WORDS 3456
#define XB_SPIN_CAP (1u << 18)

__device__ __forceinline__ unsigned xb_ld(unsigned* p)              { return __hip_atomic_load(p, __ATOMIC_RELAXED, __HIP_MEMORY_SCOPE_AGENT); }
__device__ __forceinline__ unsigned xb_add(unsigned* p, unsigned v) { return __hip_atomic_fetch_add(p, v, __ATOMIC_RELAXED, __HIP_MEMORY_SCOPE_AGENT); }
__device__ __forceinline__ unsigned xb_xcc_id() { return (unsigned)__builtin_amdgcn_s_getreg((3 << 11) | 20) & 0xFu; }
#define XB_SPIN(cond, bar) do { unsigned _sp = 0; while (cond) { __builtin_amdgcn_s_sleep(1); \
    if ((++_sp & 255u) == 0u) { if (xb_ld(&(bar)[XB_TMO])) break; if (_sp > XB_SPIN_CAP) { atomicAdd(&(bar)[XB_TMO], 1u); break; } } } } while (0)

struct XcdBarrier {
    unsigned* bar; unsigned x;
    volatile LAS unsigned* st;
};

__device__ __forceinline__ XcdBarrier xcd_barrier_post(unsigned* bar, volatile LAS unsigned* st) {
    XcdBarrier b; b.bar = bar; b.x = xb_xcc_id(); b.st = st;
    if (threadIdx.x == 0) (void)xb_add(&bar[XB_XCNT(b.x)], 1u);
    return b;
}
__device__ __forceinline__ void xcd_barrier_complete(unsigned* bar, unsigned x, unsigned& nloc, unsigned& nx) {
    const unsigned G = gridDim.x * gridDim.y * gridDim.z;
    unsigned sum, cnt, mine, sp = 0u;
    for (;;) {
        sum = 0u; cnt = 0u; mine = 0u;
#pragma unroll
        for (unsigned j = 0; j < 16; ++j) { const unsigned c = xb_ld(&bar[XB_XCNT(j)]); sum += c; cnt += (c > 0u) ? 1u : 0u; mine = (j == x) ? c : mine; }
        if (sum == G) break;
        __builtin_amdgcn_s_sleep(1);
        if ((++sp & 255u) == 0u) { if (xb_ld(&bar[XB_TMO])) break; if (sp > XB_SPIN_CAP) { atomicAdd(&bar[XB_TMO], 1u); break; } }
    }
    nloc = mine > 0u ? mine : 1u; nx = cnt > 0u ? cnt : 1u;
}

__device__ __forceinline__ void xcd_barrier(const XcdBarrier& b) {
    asm volatile("s_waitcnt vmcnt(0)" ::: "memory");
    __syncthreads();
    if (threadIdx.x == 0) {
        unsigned* bar = b.bar;
        __builtin_amdgcn_s_waitcnt(0);
        unsigned nloc = b.st[0], nx = b.st[1];
        if (nloc == 0u) { xcd_barrier_complete(bar, b.x, nloc, nx); b.st[0] = nloc; b.st[1] = nx; }
        const unsigned old = xb_add(&bar[XB_XSUB(b.x)], 1u);
        const unsigned gen = old / nloc;
        if (old + 1u == (gen + 1u) * nloc) {
            __builtin_amdgcn_fence(__ATOMIC_RELEASE, "agent");
            asm volatile("s_waitcnt vmcnt(0)" ::: "memory");
            const unsigned og = xb_add(&bar[XB_TOP], 1u);
            const unsigned tg = og / nx;
            if (og + 1u == (tg + 1u) * nx) xb_add(&bar[XB_TOPGEN], 1u);
            else XB_SPIN(xb_ld(&bar[XB_TOPGEN]) == tg, bar);
            __builtin_amdgcn_fence(__ATOMIC_ACQUIRE, "agent");
            xb_add(&bar[XB_XGEN(b.x)], 1u);
            asm volatile("s_waitcnt vmcnt(0)" ::: "memory");
        } else {
            XB_SPIN(xb_ld(&bar[XB_XGEN(b.x)]) == gen, bar);
            __builtin_amdgcn_fence(__ATOMIC_ACQUIRE, "agent");
            asm volatile("s_waitcnt vmcnt(0)" ::: "memory");
        }
    }
    __syncthreads();
}

struct Frame {
    LAS unsigned char* lds;
    int tid, lane, wave, G, vcu;
};
__device__ __forceinline__ float wave_sum(float v) {
#pragma unroll
    for (int o = 1; o < 64; o <<= 1) v += __shfl_xor(v, o);
    return v;
}
__device__ __forceinline__ unsigned f2bf(float f) { unsigned u = __builtin_bit_cast(unsigned, f); return (u + 0x7fffu + ((u >> 16) & 1u)) >> 16; }
__device__ __forceinline__ unsigned pk2(float lo, float hi) { return cvtpk(lo, hi); }

__device__ __forceinline__ void xpose_load(const float* W, int ldw, int src_col0, int k0, int lane, f32x4 (&v)[8]) {
    const int kc = lane & 7, ng = lane >> 3;
    if (src_col0 < 0) {
#pragma unroll
        for (int e = 0; e < 8; ++e) v[e] = (f32x4){0.f, 0.f, 0.f, 0.f};
        return; }
    const float* p = W + (size_t)(k0 + 8 * kc) * ldw + src_col0 + 4 * ng;
#pragma unroll
    for (int e = 0; e < 8; ++e) v[e] = __builtin_nontemporal_load((const GAS f32x4*)(p + (size_t)e * ldw));
}
__device__ __forceinline__ void xpose_store(const f32x4 (&v)[8], const float* gain, bf16* WT, int K, int dst_row0, int k0, int lane) {
    const int kc = lane & 7, ng = lane >> 3;
    f32x4 g0 = {1.f, 1.f, 1.f, 1.f}, g1 = g0;
    if (gain) { g0 = *(const GAS f32x4*)(gain + k0 + 8 * kc); g1 = *(const GAS f32x4*)(gain + k0 + 8 * kc + 4); }
    bf16* o = WT + (size_t)(dst_row0 + 4 * ng) * K + k0 + 8 * kc;
#pragma unroll
    for (int i = 0; i < 4; ++i) { v4u w; w.x = pk2(v[0][i] * g0[0], v[1][i] * g0[1]); w.y = pk2(v[2][i] * g0[2], v[3][i] * g0[3]); w.z = pk2(v[4][i] * g1[0], v[5][i] * g1[1]); w.w = pk2(v[6][i] * g1[2], v[7][i] * g1[3]);
        *(GAS v4u*)(o + (size_t)i * K) = w; }
}
__device__ __forceinline__ void xpose_store8(const f32x4 (&v)[8], const float* gain, float scale, unsigned char* WT, int K, int dst_row0, int k0, int lane) {
    const int kc = lane & 7, ng = lane >> 3;
    f32x4 g0 = {scale, scale, scale, scale}, g1 = g0;
    if (gain) { g0 = *(const GAS f32x4*)(gain + k0 + 8 * kc) * scale; g1 = *(const GAS f32x4*)(gain + k0 + 8 * kc + 4) * scale; }
    unsigned char* o = WT + (size_t)(dst_row0 + 4 * ng) * K + k0 + 8 * kc;
#pragma unroll
    for (int i = 0; i < 4; ++i) { *(GAS v2u*)(o + (size_t)i * K) = pg8::pack8_fp8((f32x4){v[0][i] * g0[0], v[1][i] * g0[1], v[2][i] * g0[2], v[3][i] * g0[3]}, (f32x4){v[4][i] * g1[0], v[5][i] * g1[1], v[6][i] * g1[2], v[7][i] * g1[3]}); }
}
__device__ __forceinline__ void xpose_item2(const float* Wa, int srca, const float* Wb, int srcb, int ldw, const float* gain, bf16* WT, int K, int dst_row0, int k0, int lane) {
    f32x4 va[8], vb[8];
    xpose_load(Wa, ldw, srca, k0, lane, va); xpose_load(Wb, ldw, srcb, k0, lane, vb);
    xpose_store(va, gain, WT, K, dst_row0, k0, lane); xpose_store(vb, gain, WT, K, dst_row0 + 32, k0, lane);
}
__device__ __forceinline__ void sincos_acc(float ang, float& sn, float& cs) {
    const double a = (double)ang; const double kq = __builtin_rint(a * 0.6366197723675814); const double r = __builtin_fma(-kq, 1.5707963267948966, a) - kq * 6.123233995736766e-17;
    const double r2 = r * r;
    double sp = 1.6059043836821613e-10; sp = sp * r2 - 2.505210838544172e-08; sp = sp * r2 + 2.7557319223985893e-06; sp = sp * r2 - 0.0001984126984126984; sp = sp * r2 + 0.008333333333333333; sp = sp * r2 - 0.16666666666666666; sp = sp * r2 * r + r;
    double cp = 2.08767569878681e-09; cp = cp * r2 - 2.755731922398589e-07; cp = cp * r2 + 2.48015873015873e-05; cp = cp * r2 - 0.001388888888888889; cp = cp * r2 + 0.041666666666666664; cp = cp * r2 - 0.5; cp = cp * r2 + 1.0;
    const int q = (int)kq & 3;
    const double s = (q == 0) ? sp : (q == 1) ? cp : (q == 2) ? -sp : -cp;
    const double c = (q == 0) ? cp : (q == 1) ? -sp : (q == 2) ? -cp : sp;
    sn = (float)s; cs = (float)c;
}

struct In { const float *x, *p, *w_in, *g_attn, *g_q, *g_kv, *w_uq, *w_ukv, *w_o, *g_ffn, *w_gate, *w_up, *conv_w, *conv_b, *w_down, *g_ple, *w_pg, *w_pp, *g_final; };
struct Args { In in; float* out; unsigned char* ws; int ph_lo, ph_hi; };

__device__ __forceinline__ double ipow_d(double c, int j, int nbits) { double inv = 1.0, p = c; for (int b = 0; b < nbits; ++b) { if ((j >> b) & 1) inv *= p; p *= p; } return inv; }

__device__ __forceinline__ void p0_prologue(Frame& F, const In& I, unsigned char* ws) {
    const int gw = F.vcu * NWAVES + F.wave, NGW = F.G * NWAVES, lane = F.lane;
    bf16* Win_t = (bf16*)(ws + WS_WIN); unsigned char* Win8_t = ws + WS_WIN8; unsigned char* Wuq8_t = ws + WS_WUQ; unsigned char* Wukv8_t = ws + WS_WUKV;
    constexpr int I_IN = 128 * 64, I_IN8 = 28 * 64, I_UQ = 48 * 16, I_UKV = 64 * 8, I_PP = 64 * 4, NITEMS = I_IN + I_IN8 + I_UQ + I_UKV + I_PP;
    for (int it = gw; it < NITEMS; it += NGW) {
        int r = it;
        if (r < I_IN) { const int n0 = 64 * (r >> 6), k0 = 64 * (r & 63); xpose_item2(I.w_in, n0, I.w_in, n0 + 32, 9792, nullptr, Win_t, 4096, n0, k0, lane); continue; } r -= I_IN;
        if (r < I_IN8) { const int n0 = 64 * (r >> 6), k0 = 64 * (r & 63); int sa = 8192 + n0, sb = 8192 + n0 + 32;
            if (n0 >= 1536) { const int c = n0 - 1536; sa = (c == 0) ? 9728 : (c == 128 ? 9760 : -1); sb = -1; }
            f32x4 va[8], vb[8]; xpose_load(I.w_in, 9792, sa, k0, lane, va); xpose_load(I.w_in, 9792, sb, k0, lane, vb);
            xpose_store8(va, nullptr, pg8::W8_SCALE, Win8_t, 4096, n0, k0, lane); xpose_store8(vb, nullptr, pg8::W8_SCALE, Win8_t, 4096, n0 + 32, k0, lane); continue; } r -= I_IN8;
        if (r < I_UQ) { const int n0 = 64 * (r >> 4), k0 = 64 * (r & 15), pn = n0 >> 8; int sa, sb;
            { const int c = n0 & 255; if (pn < 8) sa = 192 * (2 * pn + (c >> 7)) + (c & 127); else sa = 192 * (4 * (pn - 8) + ((c & 127) >> 5)) + 128 + 32 * (c >> 7); }
            { const int c = (n0 + 32) & 255; if (pn < 8) sb = 192 * (2 * pn + (c >> 7)) + (c & 127); else sb = 192 * (4 * (pn - 8) + ((c & 127) >> 5)) + 128 + 32 * (c >> 7); }
            { f32x4 va[8], vb[8]; xpose_load(I.w_uq, 3072, sa, k0, lane, va); xpose_load(I.w_uq, 3072, sb, k0, lane, vb); xpose_store8(va, I.g_q, pg8::WQ8_SCALE, Wuq8_t, 1024, n0, k0, lane); xpose_store8(vb, I.g_q, pg8::WQ8_SCALE, Wuq8_t, 1024, n0 + 32, k0, lane); } continue; } r -= I_UQ;
        if (r >= I_UKV) { r -= I_UKV; const int n0 = 64 * (r >> 2), k0 = 64 * (r & 3); xpose_item2(I.w_pp, n0, I.w_pp, n0 + 32, 4096, nullptr, (bf16*)(ws + WS_WPP), 256, n0, k0, lane); continue; }
        { const int n0 = 64 * (r >> 3), k0 = 64 * (r & 7); f32x4 va[8], vb[8]; xpose_load(I.w_ukv, 4096, n0, k0, lane, va); xpose_load(I.w_ukv, 4096, n0 + 32, k0, lane, vb); xpose_store8(va, I.g_kv, pg8::WQ8_SCALE, Wukv8_t, 512, n0, k0, lane); xpose_store8(vb, I.g_kv, pg8::WQ8_SCALE, Wukv8_t, 512, n0 + 32, k0, lane); }
    }
    bf16* XB = (bf16*)(ws + WS_XB);
    for (int m = gw; m < M; m += NGW) {
        const GAS f32x4* xr = (const GAS f32x4*)(I.x + (size_t)m * DM) + lane; const GAS f32x4* gr = (const GAS f32x4*)I.g_attn + lane;
        f32x4 v[16]; float s = 0.f;
#pragma unroll
        for (int j = 0; j < 16; ++j) { v[j] = __builtin_nontemporal_load(xr + 64 * j); s += (v[j].x * v[j].x + v[j].y * v[j].y) + (v[j].z * v[j].z + v[j].w * v[j].w); }
        const float rstd = 1.0f / sqrtf(wave_sum(s) * (1.0f / DM) + 1e-6f);
        GAS v2u* o8 = (GAS v2u*)(XB + (size_t)m * DM) + lane; GAS unsigned* o1 = (GAS unsigned*)(ws + WS_XB8 + (size_t)m * DM) + lane;
#pragma unroll
        for (int j = 0; j < 16; ++j) { const f32x4 g = gr[64 * j]; const float y0 = v[j].x * rstd * g.x, y1 = v[j].y * rstd * g.y, y2 = v[j].z * rstd * g.z, y3 = v[j].w * rstd * g.w;
            v2u o; o.x = pk2(y0, y1); o.y = pk2(y2, y3); o8[64 * j] = o;
            int w8 = __builtin_amdgcn_cvt_pk_fp8_f32(y0, y1, 0, false); w8 = __builtin_amdgcn_cvt_pk_fp8_f32(y2, y3, w8, true); o1[64 * j] = (unsigned)w8; }
    }
    { bf16* PB = (bf16*)(ws + WS_PB);
      for (int i = gw * 64 + lane; i < M * 256 / 8; i += NGW * 64) { const f32x4 a = *(const GAS f32x4*)(I.p + (size_t)i * 8), b = *(const GAS f32x4*)(I.p + (size_t)i * 8 + 4);
          v4u o; o.x = pk2(a.x, a.y); o.y = pk2(a.z, a.w); o.z = pk2(b.x, b.y); o.w = pk2(b.z, b.w); *(GAS v4u*)(PB + (size_t)i * 8) = o; } }
    { float* cosR = (float*)(ws + WS_COSR); float* sinR = (float*)(ws + WS_SINR); float* cosM = (float*)(ws + WS_COSM); float* sinM = (float*)(ws + WS_SINM);
      for (int i = gw * 64 + lane; i < SEQ * 160; i += NGW * 64) {
          if (i < SEQ * 128) { const int pos = i >> 7, j = i & 127; const float inv = (float)ipow_d(0.930572040929699, j, 7); float sn, cs; sincos_acc((float)pos * inv, sn, cs); cosR[i] = cs; sinR[i] = sn; }
          else { const int k = i - SEQ * 128, pos = k >> 5, j = k & 31; const float inv = (float)ipow_d(0.7498942093324559, j, 5); float sn, cs; sincos_acc((float)pos * inv, sn, cs); cosM[k] = cs; sinM[k] = sn; } } }
}

constexpr int CV_O = 128 * 64, CV_GU = 688 * 64, CV_N = CV_O + CV_GU;
constexpr int CV_PRE = CV_O;
__device__ __forceinline__ void cv_load(const In& I, int it, int lane, f32x4 (&v)[8]) {
    if (it < CV_O) { xpose_load(I.w_o, 4096, 32 * (it >> 6), 64 * (it & 63), lane, v); return; }
    const int r = it - CV_O, n0 = 32 * (r >> 6), k0 = 64 * (r & 63), pn = n0 >> 8, cc = n0 & 255, src = 128 * pn + (cc & 127);
    if (cc < 128) xpose_load(I.w_gate, NFF, src, k0, lane, v); else xpose_load(I.w_up, NFF, src, k0, lane, v);
}
__device__ __forceinline__ void cv_store(const In& I, unsigned char* ws, int it, int lane, const f32x4 (&v)[8]) {
    if (it < CV_O) { const int n0 = 32 * (it >> 6), k0 = 64 * (it & 63);
        if (k0 < 2048) xpose_store(v, nullptr, (bf16*)(ws + WS_WO), CCP, n0, k0, lane); else xpose_store8(v, nullptr, pg8::W8_SCALE, ws + WS_WO + 4096, 2 * CCP, n0, k0 - 2048, lane); return; }
    const int r = it - CV_O; xpose_store(v, I.g_ffn, (bf16*)(ws + WS_WGU), 4096, 32 * (r >> 6), 64 * (r & 63), lane);
}
__device__ __forceinline__ void cvg_load(const In& I, int it, int lane, f32x4 (&v)[8]) {
    const int r = it - CV_O, n0 = 32 * (r >> 6), k0 = 64 * (r & 63), pn = n0 >> 8, cc = n0 & 255, src = 128 * pn + (cc & 127);
    if (cc < 128) xpose_load(I.w_gate, NFF, src, k0, lane, v); else xpose_load(I.w_up, NFF, src, k0, lane, v);
}
__device__ __forceinline__ void cvg_store(const In& I, unsigned char* ws, int it, int lane, const f32x4 (&v)[8]) {
    const int r = it - CV_O; xpose_store(v, I.g_ffn, (bf16*)(ws + WS_WGU), 4096, 32 * (r >> 6), 64 * (r & 63), lane);
}
__device__ __forceinline__ void pre_convert(Frame& F, const In& I, unsigned char* ws, int rank, int nranks, int n_items) {
    const int gw = rank * NWAVES + F.wave, NGW = nranks * NWAVES, lane = F.lane;
    for (int it = gw; it < n_items; it += 2 * NGW) { f32x4 va[8], vb[8]; const int it2 = it + NGW;
        cv_load(I, it, lane, va); if (it2 < n_items) cv_load(I, it2, lane, vb);
        cv_store(I, ws, it, lane, va); if (it2 < n_items) cv_store(I, ws, it2, lane, vb); }
}
namespace ret {
constexpr int LQ = 0, LK = 32768, LV = 65536, LV2 = 69632, LS = 73728, LRED = 106496;
__device__ __forceinline__ int off_k(int row, int ch) { return 4096 * (row >> 3) + 512 * (ch >> 2) + 64 * (row & 7) + 16 * ((ch & 3) ^ ((row >> 2) & 3)); }
__device__ __forceinline__ int off_v(int row, int ch) { return 512 * (row >> 3) + 64 * (row & 7) + 16 * (ch ^ ((row >> 2) & 3)); }
}
__device__ __forceinline__ void retention_phase(Frame& F, const In& I, unsigned char* ws, int cv_base) {
    using namespace ret;
    LAS unsigned char* lds = F.lds;
    const int tid = F.tid, lane = F.lane, wid = F.wave, r32 = lane & 31, hi = lane >> 5;
    const bf16* PJ = (const bf16*)(ws + WS_PROJ); bf16* CC = (bf16*)(ws + WS_XB); float* ST = (float*)(ws + WS_STATS);
    const int rowpart = 4096 * (r32 >> 3) + 64 * (r32 & 7), xr = (r32 >> 2) & 3;
    const int baseE = rowpart + 16 * (hi ^ xr), baseO = rowpart + 16 * ((2 + hi) ^ xr);
    const int tq = (lane & 15) >> 2, tp = lane & 3, tblk = (lane >> 4) & 1;
    const int trk0 = 4096 * hi + 64 * tq + 16 * ((2 * tblk + (tp >> 1)) ^ (2 * hi)) + 8 * (tp & 1);
    const int trk1 = 4096 * hi + 64 * (4 + tq) + 16 * ((2 * tblk + (tp >> 1)) ^ (2 * hi + 1)) + 8 * (tp & 1);
    const int trv0 = 512 * hi + 64 * tq + 16 * ((2 * tblk + (tp >> 1)) ^ (2 * hi)) + 8 * (tp & 1);
    const int trv1 = 512 * hi + 64 * (4 + tq) + 16 * ((2 * tblk + (tp >> 1)) ^ (2 * hi + 1)) + 8 * (tp & 1);
    for (int unit = blockIdx.x; unit < 256; unit += F.G) {
        const int bh = (unit & 7) + 8 * ((unit >> 3) & 3), sl = unit >> 5, b = bh >> 3, h = bh & 7;
        float lg; { const double e = 1.0 / (double)(32 << h); double t = e, acc = 0.0; for (int k = 1; k <= 10; ++k) { acc += t / (double)k; t *= e; } lg = (float)(-acc * 1.4426950408889634); }
        const float a64 = exp2f(lg * 64.0f);
        const size_t rowbase = (size_t)b * SEQ;
        const bool intra = (wid < 2), inter = (wid == 2 || wid == 3 || wid == 6 || wid == 7);
        const int qb = wid & 1, dkh = (wid >> 2) & 1;
        LAS float* gt = (LAS float*)(lds + 132096);
        if (tid <= 64) gt[tid] = exp2f(lg * (float)tid);
        const int nq = 32 * qb + r32;
        f32x16 S = {};
        const int vrow = (tid >> 2) & 63, vch = tid & 3; const float kd = exp2f(lg * (float)(63 - vrow));
        v4u sq[4], sk[4], sv;
        const unsigned qoff = (unsigned)(((tid >> 5) * LDP + 8 * (tid & 31)) * 2), voffg = (unsigned)((vrow * LDP + 4096 + 32 * sl + 8 * vch) * 2);
#define RET_LOAD(c) do { const char* base_ = (const char*)(PJ + (rowbase + (size_t)(c) * 64) * LDP + h * 256); \
        _Pragma("unroll") for (int i_ = 0; i_ < 4; ++i_) { const char* rb_ = base_ + (size_t)i_ * 16 * LDP * 2; sq[i_] = *(const GAS v4u*)(rb_ + qoff); sk[i_] = *(const GAS v4u*)(rb_ + 4096 + qoff); } \
        sv = *(const GAS v4u*)(base_ + voffg); } while (0)
#define RET_WRITE() do { _Pragma("unroll") for (int i_ = 0; i_ < 4; ++i_) { const int id_ = tid + 512 * i_; const int o_ = off_k(id_ >> 5, id_ & 31); *(LAS v4u*)(lds + LQ + o_) = sq[i_]; *(LAS v4u*)(lds + LK + o_) = sk[i_]; } \
        if (tid < 256) { const int o_ = off_v(vrow, vch); *(LAS v4u*)(lds + LV + o_) = sv; v4u w_; \
            w_.x = cvtpk(bflo(sv.x) * kd, bfhi(sv.x) * kd); w_.y = cvtpk(bflo(sv.y) * kd, bfhi(sv.y) * kd); w_.z = cvtpk(bflo(sv.z) * kd, bfhi(sv.z) * kd); w_.w = cvtpk(bflo(sv.w) * kd, bfhi(sv.w) * kd); \
            *(LAS v4u*)(lds + LV2 + o_) = w_; } } while (0)
        f32x4 cva[8]; int cv_prev = -1; const int cv_slot = (unit - (int)blockIdx.x) / F.G * 384 + (wid - 2);
        RET_LOAD(0);
        for (int i = tid; i < 1024; i += 512) *(LAS v4u*)(lds + LS + 16 * i) = (v4u){0u, 0u, 0u, 0u};
        VM_WAIT(); RET_WRITE(); LDS_WAIT(); __builtin_amdgcn_s_barrier(); asm volatile("" ::: "memory");
        for (int c = 0; c < 64; ++c) {
            const int cur = c & 1;

            if (c + 1 < 64) RET_LOAD(c + 1);
            if (wid >= 2) {
                if (cv_prev >= 0) cvg_store(I, ws, cv_prev, lane, cva);
                const int it = cv_base + (cv_slot + 6 * c) * F.G + (int)blockIdx.x;
                if (it < CV_N) { cvg_load(I, it, lane, cva); cv_prev = it; } else cv_prev = -1;
            }
            if (intra) {
                f32x16 p0 = {}, p1 = {};
#pragma unroll
                for (int d0 = 0; d0 < 16; ++d0) { const int o_ = ((d0 & 1) ? baseO : baseE) + 512 * (d0 >> 1);
                    const bf16x8 a0 = *(const LAS bf16x8*)(lds + LK + o_), a1 = *(const LAS bf16x8*)(lds + LK + 16384 + o_), bq = *(const LAS bf16x8*)(lds + LQ + 16384 * qb + o_);
                    p0 = __builtin_amdgcn_mfma_f32_32x32x16_bf16(a0, bq, p0, 0, 0, 0); p1 = __builtin_amdgcn_mfma_f32_32x32x16_bf16(a1, bq, p1, 0, 0, 0); if ((d0 & 3) == 3) SBAR(); }
#pragma unroll
                for (int r = 0; r < 16; ++r) { const int m0 = crow(r, hi); p0[r] *= gt[nq > m0 ? nq - m0 : m0 - nq]; p1[r] *= gt[nq > m0 + 32 ? nq - m0 - 32 : m0 + 32 - nq]; }
                bf16x8 pa0, pa1, pa2, pa3;
#define PK4(P, B_, OUT) do { unsigned a0_ = cvtpk(P[B_ + 0], P[B_ + 1]), a1_ = cvtpk(P[B_ + 2], P[B_ + 3]); unsigned b0_ = cvtpk(P[B_ + 4], P[B_ + 5]), b1_ = cvtpk(P[B_ + 6], P[B_ + 7]); \
        auto r0_ = __builtin_amdgcn_permlane32_swap(a0_, b0_, false, false); auto r1_ = __builtin_amdgcn_permlane32_swap(a1_, b1_, false, false); \
        v4u w_ = {r0_[0], r1_[0], r0_[1], r1_[1]}; OUT = __builtin_bit_cast(bf16x8, w_); } while (0)
                PK4(p0, 0, pa0); PK4(p0, 8, pa1); PK4(p1, 0, pa2); PK4(p1, 8, pa3);
                f32x16 o = {};
#define VFRAG(img, ks) ({ const s16x4 l_ = tr_read(lds + (img) + trv0 + 1024 * (ks)), h_ = tr_read(lds + (img) + trv1 + 1024 * (ks)); (bf16x8){l_[0], l_[1], l_[2], l_[3], h_[0], h_[1], h_[2], h_[3]}; })
                o = __builtin_amdgcn_mfma_f32_32x32x16_bf16(pa0, VFRAG(LV, 0), o, 0, 0, 0); o = __builtin_amdgcn_mfma_f32_32x32x16_bf16(pa1, VFRAG(LV, 1), o, 0, 0, 0);
                o = __builtin_amdgcn_mfma_f32_32x32x16_bf16(pa2, VFRAG(LV, 2), o, 0, 0, 0); o = __builtin_amdgcn_mfma_f32_32x32x16_bf16(pa3, VFRAG(LV, 3), o, 0, 0, 0);
                LAS float* red = (LAS float*)(lds + LRED) + (qb * 3 + 0) * 1024;
#pragma unroll
                for (int r = 0; r < 16; ++r) red[crow(r, hi) * 32 + r32] = o[r];
            } else if (inter) {
                f32x16 o = {};
#pragma unroll
                for (int s8 = 0; s8 < 8; ++s8) { const int d0 = 8 * dkh + s8; const int o_ = ((d0 & 1) ? baseO : baseE) + 512 * (d0 >> 1);
                    const bf16x8 aq = *(const LAS bf16x8*)(lds + LQ + 16384 * qb + o_), bs = *(const LAS bf16x8*)(lds + LS + 16384 * cur + o_);
                    o = __builtin_amdgcn_mfma_f32_32x32x16_bf16(aq, bs, o, 0, 0, 0); }
                LAS float* red = (LAS float*)(lds + LRED) + (qb * 3 + 1 + dkh) * 1024;
#pragma unroll
                for (int r = 0; r < 16; ++r) red[crow(r, hi) * 32 + r32] = o[r] * gt[32 * qb + crow(r, hi) + 1];
            }
#pragma unroll
            for (int r = 0; r < 16; ++r) S[r] *= a64;
#pragma unroll
            for (int ks = 0; ks < 4; ++ks) { const s16x4 l_ = tr_read(lds + LK + trk0 + 8192 * ks + 512 * wid), h_ = tr_read(lds + LK + trk1 + 8192 * ks + 512 * wid);
                const bf16x8 ak = (bf16x8){l_[0], l_[1], l_[2], l_[3], h_[0], h_[1], h_[2], h_[3]};
                S = __builtin_amdgcn_mfma_f32_32x32x16_bf16(ak, VFRAG(LV2, ks), S, 0, 0, 0); }
#pragma unroll
            for (int g = 0; g < 4; ++g) { v2u w_; w_.x = cvtpk(S[4 * g], S[4 * g + 1]); w_.y = cvtpk(S[4 * g + 2], S[4 * g + 3]);
                *(LAS v2u*)(lds + LS + 16384 * (cur ^ 1) + off_k(r32, 4 * wid + g) + 8 * hi) = w_; }
            LDS_WAIT(); __builtin_amdgcn_s_barrier(); asm volatile("" ::: "memory");
            { const int n = tid >> 3, cg = tid & 7, qb2 = n >> 5, row = n & 31;
              const LAS float* rp = (const LAS float*)(lds + LRED) + (qb2 * 3) * 1024 + row * 32 + 4 * cg;
              const f32x4 v = *(const LAS f32x4*)rp + *(const LAS f32x4*)(rp + 1024) + *(const LAS f32x4*)(rp + 2048);
              float s1 = (v[0] + v[1]) + (v[2] + v[3]), s2 = (v[0] * v[0] + v[1] * v[1]) + (v[2] * v[2] + v[3] * v[3]);
              s1 += __shfl_xor(s1, 1); s2 += __shfl_xor(s2, 1); s1 += __shfl_xor(s1, 2); s2 += __shfl_xor(s2, 2); s1 += __shfl_xor(s1, 4); s2 += __shfl_xor(s2, 4);
              const size_t t = rowbase + (size_t)c * 64 + n;
              v2u w_; w_.x = cvtpk(v[0], v[1]); w_.y = cvtpk(v[2], v[3]);
              *(GAS v2u*)(CC + t * CCP + h * 256 + 32 * sl + 4 * cg) = w_;
              if (cg == 0) { float* sp = ST + ((t * 8 + h) * 8 + sl) * 2; sp[0] = s1; sp[1] = s2; } }
            if (c + 1 < 64) { RET_WRITE(); }
            LDS_WAIT(); __builtin_amdgcn_s_barrier(); asm volatile("" ::: "memory");
        }
        if (wid >= 2 && cv_prev >= 0) cvg_store(I, ws, cv_prev, lane, cva);
#undef RET_LOAD
#undef RET_WRITE
#undef PK4
    }
}

__device__ __forceinline__ void ro_finalize(Frame& F, unsigned char* ws) {
    const int gw = F.vcu * NWAVES + F.wave, NGW = F.G * NWAVES, lane = F.lane;
    bf16* CC = (bf16*)(ws + WS_XB); const bf16* PJ = (const bf16*)(ws + WS_PROJ); const float* ST = (const float*)(ws + WS_STATS);
    for (int it0 = gw; it0 < M * 8; it0 += 4 * NGW) {
        f32x4 st[4][4]; v2u rv[4], gv[4];
#pragma unroll
        for (int k = 0; k < 4; ++k) { const int it = it0 + k * NGW; if (it < M * 8) { const size_t t = (size_t)(it >> 3); const int h = it & 7; const f32x4* sp = (const f32x4*)(ST + (size_t)it * 16);
            st[k][0] = sp[0]; st[k][1] = sp[1]; st[k][2] = sp[2]; st[k][3] = sp[3]; rv[k] = *(const GAS v2u*)(CC + t * CCP + h * 256 + 4 * lane); gv[k] = *(const GAS v2u*)(PJ + t * LDP + 6144 + h * 256 + 4 * lane); } }
#pragma unroll
        for (int k = 0; k < 4; ++k) { const int it = it0 + k * NGW; if (it < M * 8) { const size_t t = (size_t)(it >> 3); const int h = it & 7;
            const f32x4 a = st[k][0], b = st[k][1], c = st[k][2], d = st[k][3];
            const float s1 = ((a[0] + a[2]) + (b[0] + b[2])) + ((c[0] + c[2]) + (d[0] + d[2])), s2 = ((a[1] + a[3]) + (b[1] + b[3])) + ((c[1] + c[3]) + (d[1] + d[3]));
            const float mu = s1 * (1.0f / 256.0f), var = fmaxf(s2 * (1.0f / 256.0f) - mu * mu, 0.f), rstd = 1.0f / sqrtf(var + 1e-6f);
            float r[4] = {bflo(rv[k].x), bfhi(rv[k].x), bflo(rv[k].y), bfhi(rv[k].y)}, g[4] = {bflo(gv[k].x), bfhi(gv[k].x), bflo(gv[k].y), bfhi(gv[k].y)}, o[4];
#pragma unroll
            for (int i = 0; i < 4; ++i) { const float sg = g[i] / (1.0f + __expf(-g[i])); o[i] = (r[i] - mu) * rstd * sg; }
            v2u w; w.x = pk2(o[0], o[1]); w.y = pk2(o[2], o[3]); *(GAS v2u*)(CC + t * CCP + h * 256 + 4 * lane) = w; } }
    }
}

namespace att {
constexpr int KT = 12288, VT = 8192, LK0 = 0, LV0 = 2 * KT, LWS = 132096;
constexpr float SCALE = 0.07216878364870322f, C2 = 0.10411754627697264f, THR = 5.f;
__device__ __forceinline__ int off_k8(int row, int ch) { return 192 * row + 64 * (ch >> 2) + 16 * ((ch & 3) ^ ((row >> 2) & 3)); }
__device__ __forceinline__ int off_v8(int row, int ch) { return 64 * row + 16 * (ch ^ ((row >> 2) & 3)); }
typedef int v8i32 __attribute__((ext_vector_type(8)));
typedef int v4i32 __attribute__((ext_vector_type(4)));
}
__device__ __forceinline__ void attn_unit(Frame& F, unsigned char* ws, int b, int h, int qblk) {
    using namespace att;
    LAS unsigned char* lds = F.lds;
    const int tid = F.tid, lane = F.lane, wid = F.wave, r32 = lane & 31, hi = lane >> 5;
    const size_t rowbase = (size_t)b * SEQ; const int q0 = 256 * qblk, NT = 4 * qblk + 4, my_last = 4 * qblk + (wid >> 1);
    LAS float* wsf = (LAS float*)(lds + LWS) + wid * 64;
    const rsrc_t rs = make_rsrc(ws);
    v4u sk0, sk1, sv;
    const unsigned knoff = (unsigned)((tid >> 3) * 2048 + 16 * (tid & 7)), kroff = (unsigned)(((tid >> 2) & 63) * 64 + 16 * (tid & 3)), vtoff = (unsigned)((tid >> 2) * 4096 + 16 * (tid & 3));
    const unsigned vbase_g = (unsigned)WS_VB + (unsigned)((b * 16 + h) * 128) * 4096u;
#define AT_LOAD(t) do { const unsigned kr_ = (unsigned)(rowbase + (size_t)(t) * 64); \
        sk0 = bufld16(rs, knoff, (unsigned)WS_KB + kr_ * 2048u + 128u * h); if (tid < 256) sk1 = bufld16(rs, kroff, (unsigned)WS_KR + kr_ * 64u); \
        sv = bufld16(rs, vtoff, vbase_g + 64u * (unsigned)(t)); } while (0)
#define AT_WRITE(buf) do { *(LAS v4u*)(lds + LK0 + (buf) * KT + off_k8(tid >> 3, tid & 7)) = sk0; if (tid < 256) *(LAS v4u*)(lds + LK0 + (buf) * KT + off_k8(tid >> 2, 8 + (tid & 3))) = sk1; \
        *(LAS v4u*)(lds + LV0 + (buf) * VT + off_v8(tid >> 2, tid & 3)) = sv; } while (0)
    v8i32 qf[3];
    { const unsigned qv = (unsigned)(r32 * 3072 + 32 * hi), qs = (unsigned)WS_Q + (unsigned)((rowbase + q0 + 32 * wid) * 3072 + 192 * h);
#pragma unroll
      for (int s = 0; s < 3; ++s) { qf[s].lo = __builtin_bit_cast(v4i32, bufld16(rs, qv, qs + 64 * s)); qf[s].hi = __builtin_bit_cast(v4i32, bufld16(rs, qv, qs + 64 * s + 16)); } }
    const int xk = (r32 >> 2) & 3;
    const int kb0 = 192 * r32 + 16 * ((2 * hi) ^ xk), kb1 = 192 * r32 + 16 * ((2 * hi + 1) ^ xk);
    const int vb0 = 64 * r32 + 16 * ((2 * hi) ^ xk), vb1 = 64 * r32 + 16 * ((2 * hi + 1) ^ xk);
    const int unit_scale = 0x7f7f7f7f;
    float m_reg = -1e30f, l_reg = 0.f; f32x16 o[4] = {};
    AT_LOAD(0); VM_WAIT(); AT_WRITE(0);
    if (NT > 1) AT_LOAD(1);
    LDS_WAIT(); __builtin_amdgcn_s_barrier(); asm volatile("" ::: "memory");
    for (int t = 0; t < NT; ++t) {
        const int buf = t & 1;
        const bool active = (t <= my_last);
        if (!active && t + 1 < NT) { AT_WRITE(buf ^ 1); if (t + 2 < NT) AT_LOAD(t + 2); }
        if (active) {
            f32x16 p0 = {}, p1 = {};
            const LAS unsigned char* kbase = lds + LK0 + buf * KT;
#pragma unroll
            for (int s = 0; s < 3; ++s) { v8i32 k0, k1;
                k0.lo = *(const LAS v4i32*)(kbase + kb0 + 64 * s); k0.hi = *(const LAS v4i32*)(kbase + kb1 + 64 * s); k1.lo = *(const LAS v4i32*)(kbase + 6144 + kb0 + 64 * s); k1.hi = *(const LAS v4i32*)(kbase + 6144 + kb1 + 64 * s);
                p0 = __builtin_amdgcn_mfma_scale_f32_32x32x64_f8f6f4(k0, qf[s], p0, 0, 0, 0, unit_scale, 0, unit_scale); p1 = __builtin_amdgcn_mfma_scale_f32_32x32x64_f8f6f4(k1, qf[s], p1, 0, 0, 0, unit_scale, 0, unit_scale); }
            if (t + 1 < NT) { AT_WRITE(buf ^ 1); if (t + 2 < NT) AT_LOAD(t + 2); }
            float pmax = p0[0];
#pragma unroll
            for (int r = 1; r < 16; ++r) pmax = fmaxf(pmax, p0[r]);
#pragma unroll
            for (int r = 0; r < 16; ++r) pmax = fmaxf(pmax, p1[r]);
            { auto rr = __builtin_amdgcn_permlane32_swap(__float_as_uint(pmax), __float_as_uint(pmax), false, false); pmax = fmaxf(__uint_as_float(rr[0]), __uint_as_float(rr[1])); }
            float mn, alpha;
            if (__all((pmax - m_reg) * SCALE <= THR)) { mn = m_reg; alpha = 1.f; }
            else { mn = fmaxf(m_reg, pmax); alpha = __builtin_amdgcn_exp2f((m_reg - mn) * C2); m_reg = mn; }
            const float mnL = -mn * C2;
#pragma unroll
            for (int r = 0; r < 16; ++r) { p0[r] = __builtin_amdgcn_exp2f(fmaf(p0[r], C2, mnL)); p1[r] = __builtin_amdgcn_exp2f(fmaf(p1[r], C2, mnL)); }
            float ps = 0.f;
#pragma unroll
            for (int r = 0; r < 16; ++r) ps += p0[r] + p1[r];
            { auto rr = __builtin_amdgcn_permlane32_swap(__float_as_uint(ps), __float_as_uint(ps), false, false); ps = __uint_as_float(rr[0]) + __uint_as_float(rr[1]); }
            l_reg = l_reg * alpha + ps;
            if (__any(alpha < 1.f)) { if (hi == 0) wsf[r32] = alpha; LDS_WAIT();
#pragma unroll
                for (int r = 0; r < 16; ++r) { const float al = wsf[crow(r, hi)];
#pragma unroll
                    for (int c = 0; c < 4; ++c) o[c][r] *= al; } }
            v8i32 P8;
#pragma unroll
            for (int d = 0; d < 4; ++d) { int w0 = __builtin_amdgcn_cvt_pk_fp8_f32(p0[4 * d], p0[4 * d + 1], 0, false); w0 = __builtin_amdgcn_cvt_pk_fp8_f32(p0[4 * d + 2], p0[4 * d + 3], w0, true); P8[d] = w0;
                int w1 = __builtin_amdgcn_cvt_pk_fp8_f32(p1[4 * d], p1[4 * d + 1], 0, false); w1 = __builtin_amdgcn_cvt_pk_fp8_f32(p1[4 * d + 2], p1[4 * d + 3], w1, true); P8[4 + d] = w1; }
            const LAS unsigned char* vbase = lds + LV0 + buf * VT;
#pragma unroll
            for (int c = 0; c < 4; ++c) { v8i32 vf; vf.lo = *(const LAS v4i32*)(vbase + vb0 + 2048 * c); vf.hi = *(const LAS v4i32*)(vbase + vb1 + 2048 * c);
                o[c] = __builtin_amdgcn_mfma_scale_f32_32x32x64_f8f6f4(P8, vf, o[c], 0, 0, 0, unit_scale, 0, unit_scale); }
        }
        LDS_WAIT(); __builtin_amdgcn_s_barrier(); asm volatile("" ::: "memory");
    }
    if (hi == 0) wsf[r32] = l_reg;
    { LAS float* og = (LAS float*)(lds + wid * 16384);
#pragma unroll
      for (int c = 0; c < 4; ++c)
#pragma unroll
          for (int r = 0; r < 16; ++r) og[crow(r, hi) * 128 + 32 * c + r32] = o[c][r];
      LDS_WAIT();
      const unsigned obase = (unsigned)WS_XB + (unsigned)((rowbase + q0 + 32 * wid) * (2 * CCP) + 4096 + 128 * h);
      const unsigned ooff = (unsigned)((lane >> 4) * (2 * CCP) + 8 * (lane & 15));
#pragma unroll
      for (int j = 0; j < 8; ++j) { const int row = (lane >> 4) + 4 * j; const float rl = MO8_SCALE * __builtin_amdgcn_rcpf(wsf[row]);
          const f32x4 a = *(const LAS f32x4*)(og + row * 128 + 8 * (lane & 15)), bq = *(const LAS f32x4*)(og + row * 128 + 8 * (lane & 15) + 4);
          const v2u w = __builtin_bit_cast(v2u, pg8::pack8_fp8(a * rl, bq * rl));
          __builtin_amdgcn_raw_buffer_store_b64(w, rs, (int)ooff, (int)(obase + (unsigned)(j * 4 * 2 * CCP)), 0); } }
    LDS_WAIT(); __builtin_amdgcn_s_barrier(); asm volatile("" ::: "memory");
#undef AT_LOAD
#undef AT_WRITE
}
__device__ __forceinline__ void attn_phase(Frame& F, unsigned char* ws) {
    const int G = F.G;
    for (int slot = (int)blockIdx.x; slot < 512; slot += G) {
        int it = slot;
        if ((G & 7) == 0) { const int x = slot & 7, idx = slot >> 3; it = ((x * 8 + (idx >> 3)) << 3) | (idx & 7); }
        const int bh = it >> 3, y = it & 7;
        for (int e = 0; e < 2; ++e) attn_unit(F, ws, bh >> 4, bh & 15, e ? y : 15 - y);
    }
}

__device__ __forceinline__ void fixup_phase(Frame& F, const In& I, unsigned char* ws) {
    const int gw = F.vcu * NWAVES + F.wave, NGW = F.G * NWAVES, lane = F.lane;
    const float* GT = (const float*)(ws + WS_GT); const float* GH = (const float*)(ws + WS_GH); const float* UH = (const float*)(ws + WS_UH); bf16* ACT = (bf16*)(ws + WS_ACT);
    constexpr int NV = NFF / 4;
    for (int i = gw * 64 + lane; i < NGRP * 2 * NV; i += NGW * 64) {
        const int fv = i % NV, gj = i / NV, j = gj & 1, g = gj >> 1, f = 4 * fv; const bool first = (g & 63) == 0;
        const f32x4 z = {0.f, 0.f, 0.f, 0.f};
        const f32x4 G0 = *(const f32x4*)(GH + ((size_t)g * 2 + j) * NFF + f), U0 = *(const f32x4*)(UH + ((size_t)g * 2 + j) * NFF + f);
        const f32x4 T1 = first ? z : *(const f32x4*)(GT + ((size_t)(g - 1) * 2 + 1) * NFF + f), T0 = first ? z : *(const f32x4*)(GT + ((size_t)(g - 1) * 2 + 0) * NFF + f);
        const f32x4 G1 = j ? *(const f32x4*)(GH + ((size_t)g * 2) * NFF + f) : T1, G2 = j ? T1 : T0;
        const f32x4 w0 = *(const f32x4*)(I.conv_w + f), w1 = *(const f32x4*)(I.conv_w + NFF + f), w2 = *(const f32x4*)(I.conv_w + 2 * NFF + f), bb = *(const f32x4*)(I.conv_b + f);
        float o[4];
#pragma unroll
        for (int e = 0; e < 4; ++e) { const float a = bb[e] + w0[e] * G2[e] + w1[e] * G1[e] + w2[e] * G0[e]; o[e] = a / (1.0f + __expf(-a)) * U0[e]; }
        v2u w; w.x = pk2(o[0], o[1]); w.y = pk2(o[2], o[3]); *(GAS v2u*)(ACT + ((size_t)g * 64 + j) * NFF + f) = w;
    }
}
__device__ __forceinline__ void late_convert(Frame& F, const In& I, unsigned char* ws, int rank, int nranks) {
    const int gw = rank * NWAVES + F.wave, NGW = nranks * NWAVES, lane = F.lane;
    bf16* Wdn_t = (bf16*)(ws + WS_WDN); unsigned char* Wpg8_t = ws + WS_WPG;
    constexpr int I_DN = 64 * 172, I_PG = 64 * 64;
    for (int it = gw; it < I_DN + I_PG; it += NGW) {
        int r = it;
        if (r < I_DN) { const int n0 = 64 * (r / 172), k0 = 64 * (r % 172); xpose_item2(I.w_down, n0, I.w_down, n0 + 32, 4096, nullptr, Wdn_t, NFF, n0, k0, lane); continue; } r -= I_DN;
        { const int n0 = 64 * (r >> 6), k0 = 64 * (r & 63); f32x4 va[8], vb[8]; xpose_load(I.w_pg, 4096, n0, k0, lane, va); xpose_load(I.w_pg, 4096, n0 + 32, k0, lane, vb);
            xpose_store8(va, I.g_ple, pg8::W8_SCALE, Wpg8_t, 4096, n0, k0, lane); xpose_store8(vb, I.g_ple, pg8::W8_SCALE, Wpg8_t, 4096, n0 + 32, k0, lane); }
    }
}

__device__ __forceinline__ void final_norm(Frame& F, const In& I, float* out, const float* ssq3) {
    const int gw = F.vcu * NWAVES + F.wave, NGW = F.G * NWAVES, lane = F.lane;
    for (int m = gw; m < M; m += NGW) {
        const float rstd = 1.0f / sqrtf(ssq3[m] * (1.0f / DM) + 1e-6f);
        GAS f32x4* xr = (GAS f32x4*)(out + (size_t)m * DM) + lane; const GAS f32x4* gr = (const GAS f32x4*)I.g_final + lane;
#pragma unroll
        for (int j = 0; j < 16; ++j) { const f32x4 v = xr[64 * j], g = gr[64 * j]; xr[64 * j] = v * rstd * g; }
    }
}

constexpr int N_PHASES = 10;
#ifndef REP_QKV
#define REP_QKV 0
#endif
#ifndef P5_ASM
#define P5_ASM 0
#endif
#ifndef ALIGNV
#define ALIGNV true
#endif
#ifndef SP2V
#define SP2V true
#endif
__global__ void __launch_bounds__(NWAVES * 64, 2) fwd_kernel(Args args) {
    extern __shared__ __attribute__((aligned(16))) unsigned char lds_raw[];
    Frame F;
    F.lds = (LAS unsigned char*)lds_raw;
    F.tid = threadIdx.x; F.lane = F.tid & 63; F.wave = __builtin_amdgcn_readfirstlane(F.tid >> 6);
    F.G = gridDim.x; { const int bx = blockIdx.x; F.vcu = (F.G % 8 == 0) ? (bx % 8) * (F.G / 8) + bx / 8 : bx; }
    unsigned char* ws = args.ws; const In& I = args.in;
    gu32* ctl = (gu32*)(ws + WS_CTL);
    volatile LAS unsigned* MISC = (volatile LAS unsigned*)(F.lds + MISC_OFF);
    for (int u = F.tid; u < (LDS_BYTES - LDSCTL_OFF) / 4; u += NWAVES * 64) ((LAS unsigned*)(F.lds + LDSCTL_OFF))[u] = 0u;
    __syncthreads();
    const int lo = args.ph_lo, hi = args.ph_hi;
    const bool one_phase = (hi - lo) == 1;
    XcdBarrier bar; bar.bar = (unsigned*)(ctl + CW_BAR); bar.x = 0; bar.st = nullptr;
    if (!one_phase) bar = xcd_barrier_post((unsigned*)(ctl + CW_BAR), MISC + 8);
#ifndef ONLY_PHASE
#define ONLY_PHASE -1
#endif
#define IN(k) ((ONLY_PHASE < 0 || ONLY_PHASE == (k)) && lo <= (k) && (k) < hi)
#define SEAM(k) do { if (IN(k) && IN((k) + 1)) xcd_barrier(bar); } while (0)
    float* ssq_cq = (float*)(ws + WS_CTL + CTL_SSQ); float* ssq_ckv = ssq_cq + M; float* ssq1 = ssq_ckv + M; float* ssq2 = ssq1 + M; float* ssq3 = ssq2 + M;
    bf16* XB = (bf16*)(ws + WS_XB); bf16* PJ = (bf16*)(ws + WS_PROJ); bf16* HB = (bf16*)(ws + WS_HB); bf16* ACT = (bf16*)(ws + WS_ACT); bf16* PP = (bf16*)(ws + WS_PP);
    const float* cosR = (const float*)(ws + WS_COSR); const float* sinR = (const float*)(ws + WS_SINR); const float* cosM = (const float*)(ws + WS_COSM); const float* sinM = (const float*)(ws + WS_SINM);

    const int cv_rem = (64 * 7) % F.G;
    if (IN(0)) { p0_prologue(F, I, ws); SEAM(0); }
    if (IN(1)) {
        { pg8::Gemm g{XB, (const bf16*)(ws + WS_WIN), M, 8192, DM, DM, DM}; pg8::StaticOrder S; S.init(M, 8192, F.G, (int)blockIdx.x);
          pg8::EpiProj E{PJ, LDP, cosR, sinR};
          pg8::gemm_phase<pg8::EpiProj, pg8::StaticOrder, ALIGNV, SP2V>(F.lds, g, S, E); }
        { pg8::Gemm8 g{ws + WS_XB8, ws + WS_WIN8, M, 1792, DM, DM, DM}; pg8::StaticOrder S; S.init(M, 1792, F.G, (int)blockIdx.x);
          pg8::EpiC8 E{ws + WS_C8, ws + WS_KR, ssq_cq, ssq_ckv, cosM, sinM};
          pg8::gemm_phase8<pg8::EpiC8, pg8::StaticOrder, true>(F.lds, g, S, E); }
        if (cv_rem == 0) pre_convert(F, I, ws, (int)blockIdx.x, F.G, CV_PRE);
        else if ((int)blockIdx.x >= cv_rem) pre_convert(F, I, ws, (int)blockIdx.x - cv_rem, F.G - cv_rem, CV_PRE);
        SEAM(1);
    }
    if (IN(2)) {
        retention_phase(F, I, ws, CV_PRE);
        { pg8::Gemm8 g{ws + WS_C8, ws + WS_WUQ, M, 3072, 1024, 1536, 1024}; pg8::StaticOrder S; S.init(M, 3072, F.G, (int)blockIdx.x);
          pg8::EpiQ E{ws + WS_Q, ssq_cq, cosM, sinM};
          pg8::gemm_phase8<pg8::EpiQ, pg8::StaticOrder, false>(F.lds, g, S, E); }
        { pg8::Gemm8 g{ws + WS_C8 + 1024, ws + WS_WUKV, M, 4096, 512, 1536, 512}; pg8::StaticOrder S; S.init(M, 4096, F.G, (int)blockIdx.x);
          pg8::EpiKV E{ws + WS_KB, ws + WS_VB, ssq_ckv};
          pg8::gemm_phase8<pg8::EpiKV, pg8::StaticOrder, false>(F.lds, g, S, E); }
#if REP_QKV
        { pg8::Gemm8 g{ws + WS_C8, ws + WS_WUQ, M, 3072, 1024, 1536, 1024}; pg8::StaticOrder S; S.init(M, 3072, F.G, (int)blockIdx.x);
          pg8::EpiQ E{ws + WS_Q, ssq_cq, cosM, sinM};
          pg8::gemm_phase8<pg8::EpiQ, pg8::StaticOrder, true>(F.lds, g, S, E); }
        { pg8::Gemm8 g{ws + WS_C8 + 1024, ws + WS_WUKV, M, 4096, 512, 1536, 512}; pg8::StaticOrder S; S.init(M, 4096, F.G, (int)blockIdx.x);
          pg8::EpiKV E{ws + WS_KB, ws + WS_VB, ssq_ckv};
          pg8::gemm_phase8<pg8::EpiKV, pg8::StaticOrder, true>(F.lds, g, S, E); }
#endif
        SEAM(2);
    }
    if (IN(3)) { ro_finalize(F, ws); attn_phase(F, ws); SEAM(3); }
    if (IN(4)) {
        pg8::Gemm8 g{ws + WS_XB, ws + WS_WO, M, DM, 6144, 6144, 6144}; pg8::StaticOrder S; S.init(M, DM, F.G, (int)blockIdx.x);
        pg8::EpiResT<false> E{I.x, HB, ssq1, nullptr};
        pg8::gemm_phase8<pg8::EpiResT<false>, pg8::StaticOrder, true, 32, 0x79797979, 0x7b7b7b7b>(F.lds, g, S, E);
        SEAM(4);
    }
    if (IN(5)) {
        pg8::StaticOrder S; S.init(M, 22016, F.G, (int)blockIdx.x);
        pg8::EpiGU E{ACT, ssq1, I.conv_w, I.conv_b, (float*)(ws + WS_GT), (float*)(ws + WS_GH), (float*)(ws + WS_UH)};
#if P5_ASM
        { pg8::Gemm8 g{(const unsigned char*)HB, ws + WS_WGU, M, 22016, 2 * DM, 2 * DM, 2 * DM};
          pg8::gemm_phase8<pg8::EpiGU, pg8::StaticOrder, true, 64>(F.lds, g, S, E); }
#else
        { pg8::Gemm g{HB, (const bf16*)(ws + WS_WGU), M, 22016, DM, DM, DM};
          pg8::gemm_phase<pg8::EpiGU, pg8::StaticOrder, ALIGNV, SP2V>(F.lds, g, S, E); }
#endif
        { constexpr int nwg = 64 * 86; const int G = F.G, c = (int)blockIdx.x, rem = nwg % G;
          const int rank = rem == 0 ? c : c - rem, nranks = rem == 0 ? G : G - rem;
          if (rem == 0 || c >= rem) { late_convert(F, I, ws, rank, nranks);
            pg8::Gemm gp{(const bf16*)(ws + WS_PB), (const bf16*)(ws + WS_WPP), M, DM, 256, 256, 256}; pg8::StaticOrder Sp; Sp.init(M, DM, nranks, rank);
            pg8::EpiPlain Ep{PP, DM};
            pg8::gemm_phase<pg8::EpiPlain, pg8::StaticOrder, ALIGNV, SP2V>(F.lds, gp, Sp, Ep); } }
        SEAM(5);
    }
    if (IN(6)) { fixup_phase(F, I, ws); SEAM(6); }
    if (IN(7)) {
        { pg8::Gemm g{ACT, (const bf16*)(ws + WS_WDN), M, DM, NFF, NFF, NFF}; pg8::StaticOrder S; S.init(M, DM, F.G, (int)blockIdx.x);
          pg8::EpiResT<true> E{nullptr, HB, ssq2, ws + WS_H8};
          pg8::gemm_phase<pg8::EpiResT<true>, pg8::StaticOrder, ALIGNV, SP2V>(F.lds, g, S, E); }
        SEAM(7);
    }
    const bool fuse_final = (F.G == 256);
    if (IN(8)) {
        pg8::Gemm8 g{ws + WS_H8, ws + WS_WPG, M, DM, DM, DM, DM};
        if (fuse_final) { pg8::PanelOrder S{(int)blockIdx.x}; pg8::EpiPleFinal E{args.out, HB, PP, ssq2, ssq3, (unsigned*)(ws + WS_CTL + CTL_PCNT), I.g_final};
            pg8::gemm_phase8<pg8::EpiPleFinal, pg8::PanelOrder, true>(F.lds, g, S, E); }
        else { pg8::StaticOrder S; S.init(M, DM, F.G, (int)blockIdx.x); pg8::EpiPle E{args.out, HB, PP, ssq2, ssq3};
            pg8::gemm_phase8<pg8::EpiPle, pg8::StaticOrder, true>(F.lds, g, S, E); SEAM(8); }
    }
    if (IN(9) && !fuse_final) final_norm(F, I, args.out, ssq3);
#undef IN
#undef SEAM
}

#ifndef MK_SPLIT
#define MK_SPLIT 0
#endif
extern "C" void kernel_launch(void* const* d_in, const int* in_sizes, int n_in, void* d_out, int out_size, void* d_ws, size_t ws_size, hipStream_t stream) {
    static int grid = 0;
    if (grid == 0) {
        if (n_in != 19 || out_size != M * DM || ws_size < WS_END) { fprintf(stderr, "kernel_launch: unexpected shapes (n_in %d, out %d, ws %zu)\n", n_in, out_size, ws_size); grid = -1; return; }
        int dev = 0, cus = 0, per_cu = 0;
        if (hipGetDevice(&dev) != hipSuccess || hipDeviceGetAttribute(&cus, hipDeviceAttributeMultiprocessorCount, dev) != hipSuccess) { grid = -1; return; }
        if (hipFuncSetAttribute((const void*)fwd_kernel, hipFuncAttributeMaxDynamicSharedMemorySize, LDS_BYTES) != hipSuccess) { fprintf(stderr, "kernel_launch: hipFuncSetAttribute failed\n"); grid = -1; return; }
        if (hipOccupancyMaxActiveBlocksPerMultiprocessor(&per_cu, (const void*)fwd_kernel, NWAVES * 64, LDS_BYTES) != hipSuccess || per_cu < 1) { fprintf(stderr, "kernel_launch: occupancy query says %d\n", per_cu); }
        (void)hipGetLastError();
        grid = cus;
    }
    if (grid < 0) return;
    if (hipMemsetAsync((char*)d_ws + WS_CTL, 0, CTL_ZERO_BYTES, stream) != hipSuccess) return;
    Args a{};
    const float** ip = (const float**)&a.in;
    for (int i = 0; i < 19; ++i) ip[i] = (const float*)d_in[i];
    a.out = (float*)d_out; a.ws = (unsigned char*)d_ws;
#if MK_SPLIT
    for (int ph = 0; ph < N_PHASES; ++ph) { a.ph_lo = ph; a.ph_hi = ph + 1; hipLaunchKernelGGL(fwd_kernel, dim3(grid), dim3(NWAVES * 64), LDS_BYTES, stream, a); }
#else
    a.ph_lo = 0; a.ph_hi = N_PHASES;
    hipLaunchKernelGGL(fwd_kernel, dim3(grid), dim3(NWAVES * 64), LDS_BYTES, stream, a);
#endif
}
```

```cpp
#include <hip/hip_runtime.h>
#include <cstdio>
#include <cstdint>
namespace pg8 {
#define PG8_LAS __attribute__((address_space(3)))
typedef unsigned short bf16_t;
typedef short bf16x8 __attribute__((ext_vector_type(8)));
typedef float f32x4 __attribute__((ext_vector_type(4)));
typedef unsigned u32x4 __attribute__((ext_vector_type(4)));
constexpr int BM = 256, BK = 64, HALF = 128, HTB = HALF * BK * 2  , STAGE_BYTES = 8 * HTB, NXCD = 8, WGM = 8;

__host__ __device__ __forceinline__ int lds_byte(int r, int c) { const int st = (r >> 4) * 2 + (c >> 5), rr = r & 15, cc = c & 31, ob = rr * 64 + cc * 2; return st * 1024 + (ob ^ (((ob >> 9) & 1) << 5)); }
__host__ __device__ __forceinline__ void stage_rc(int b, int& R, int& C) { const int st = b / 1024, sb = b % 1024, swz = sb ^ (((sb >> 9) & 1) << 5); R = (st >> 1) * 16 + swz / 64; C = (st & 1) * 32 + (swz % 64) / 2; }
__host__ __device__ __forceinline__ int perm32(int rho) { const int n = rho >> 4, i = rho & 15; return 8 * (i >> 2) + 4 * n + (i & 3); }

struct Unit { int pm, pn; };
struct Gemm { const bf16_t* A; const bf16_t* Bt; int M, N, K, lda, ldb; };

struct StaticOrder {
    int nM, nN, nwg, G, c, wgm;
    __host__ __device__ void init(int M, int N, int G_, int c_, int wgm_ = WGM) { nM = M / BM; nN = N / BM; nwg = nM * nN; G = G_; c = c_; wgm = wgm_; }
    __host__ __device__ bool next(int i, Unit& u) const {
        const long L = (long)i * G + c; if (L >= nwg) return false;
        int wgid = (int)L; { const int q = nwg / NXCD, r = nwg % NXCD, xcd = wgid % NXCD, off = wgid / NXCD; wgid = (xcd < r ? xcd * (q + 1) : r * (q + 1) + (xcd - r) * q) + off; }
        const int nig = wgm * nN, gid = wgid / nig, fm = gid * wgm, gsz = (nM - fm) < wgm ? (nM - fm) : wgm;
        u.pm = fm + ((wgid % nig) % gsz); u.pn = (wgid % nig) / gsz; return true;
    }
    __device__ __forceinline__ void a_ready(const Unit&) const {}
    __device__ __forceinline__ void done(const Unit&) const {}
};

typedef float f32x2c_t __attribute__((ext_vector_type(2))); typedef __bf16 bf16x2c_t __attribute__((ext_vector_type(2)));
__device__ __forceinline__ unsigned cvt_pk_bf16(float lo, float hi) { f32x2c_t v = {lo, hi}; bf16x2c_t b = __builtin_convertvector(v, bf16x2c_t); return __builtin_bit_cast(unsigned, b); }
typedef float f32x2 __attribute__((ext_vector_type(2)));

typedef unsigned u32x2 __attribute__((ext_vector_type(2)));
constexpr float RMS_EPS = 1e-6f;
__device__ __forceinline__ u32x4 pack8(const f32x4 a, const f32x4 b) { u32x4 w; w.x = cvt_pk_bf16(a[0], a[1]); w.y = cvt_pk_bf16(a[2], a[3]); w.z = cvt_pk_bf16(b[0], b[1]); w.w = cvt_pk_bf16(b[2], b[3]); return w; }
__device__ __forceinline__ float sumsq4(const f32x4 a) { return (a[0] * a[0] + a[1] * a[1]) + (a[2] * a[2] + a[3] * a[3]); }
__device__ __forceinline__ float quad_row_sum(float s) { s += __shfl_xor(s, 16); s += __shfl_xor(s, 32); return s; }
__device__ __forceinline__ void atomic_add_f32(float* p, float v) { unsafeAtomicAdd(p, v); }
__device__ __forceinline__ float bf_lo(unsigned w) { return __uint_as_float(w << 16); }
__device__ __forceinline__ float bf_hi(unsigned w) { return __uint_as_float(w & 0xffff0000u); }
__device__ __forceinline__ u32x2 pack8_fp8(const f32x4 a, const f32x4 b) {
    int w0 = __builtin_amdgcn_cvt_pk_fp8_f32(a[0], a[1], 0, false); w0 = __builtin_amdgcn_cvt_pk_fp8_f32(a[2], a[3], w0, true);
    int w1 = __builtin_amdgcn_cvt_pk_fp8_f32(b[0], b[1], 0, false); w1 = __builtin_amdgcn_cvt_pk_fp8_f32(b[2], b[3], w1, true);
    u32x2 r; r.x = (unsigned)w0; r.y = (unsigned)w1; return r; }
constexpr float WQ8_SCALE = 32.0f;
constexpr float W8_SCALE = 64.0f;

struct EpiPlain {
    static constexpr bool PERM = true, AFTER_DRAIN = false;
    bf16_t* O; int ldc;
    __device__ __forceinline__ void operator()(const f32x4 (&acc)[2][2][4][2], const Unit& u, int wr, int wc, int fr, int fq) const {
        const int row0 = u.pm * BM + wr * 64 + fr, col0 = u.pn * BM + wc * 32 + 8 * fq;
#pragma unroll
        for (int ai = 0; ai < 2; ++ai)
#pragma unroll
            for (int m = 0; m < 4; ++m) { bf16_t* rowp = O + (size_t)(row0 + ai * HALF + m * 16) * ldc + col0;
#pragma unroll
                for (int bj = 0; bj < 2; ++bj) *(u32x4*)(rowp + bj * HALF) = pack8(acc[ai][bj][m][0], acc[ai][bj][m][1]); }
    }
};

struct EpiProj {
    static constexpr bool PERM = true, AFTER_DRAIN = false;
    bf16_t* P; int ldp; const float* cosR; const float* sinR;
    __device__ __forceinline__ void operator()(const f32x4 (&acc)[2][2][4][2], const Unit& u, int wr, int wc, int fr, int fq) const {
        const int row0 = u.pm * BM + wr * 64 + fr, cl = wc * 32 + 8 * fq, pn = u.pn;
        if (pn < 16) {
            const float sc = pn >= 8 ? 0.0625f : 1.0f;
            constexpr int DEPTH = 3;
            f32x4 tc[8][2], ts[8][2];
#define EPJ_LOAD(g_) do { const int pos_ = (row0 + ((g_) >> 2) * HALF + ((g_) & 3) * 16) & 4095; const float* cp_ = cosR + (size_t)pos_ * 128 + cl; const float* sp_ = sinR + (size_t)pos_ * 128 + cl; \
                tc[g_][0] = *(const f32x4*)cp_; tc[g_][1] = *(const f32x4*)(cp_ + 4); ts[g_][0] = *(const f32x4*)sp_; ts[g_][1] = *(const f32x4*)(sp_ + 4); } while (0)
#pragma unroll
            for (int g = 0; g < DEPTH; ++g) EPJ_LOAD(g);
#pragma unroll
            for (int g = 0; g < 8; ++g) { const int ai = g >> 2, m = g & 3, row = row0 + ai * HALF + m * 16;
                f32x4 o1[2], o2[2];
#pragma unroll
                for (int n = 0; n < 2; ++n) { const f32x4 c = tc[g][n] * sc, s = ts[g][n] * sc; const f32x4 x1 = acc[ai][0][m][n], x2 = acc[ai][1][m][n];
                    o1[n] = x1 * c - x2 * s; o2[n] = x2 * c + x1 * s; }
                bf16_t* rowp = P + (size_t)row * ldp + pn * BM + cl;
                *(u32x4*)(rowp) = pack8(o1[0], o1[1]); *(u32x4*)(rowp + HALF) = pack8(o2[0], o2[1]); asm volatile("" ::: "memory");
                if (g + DEPTH < 8) EPJ_LOAD(g + DEPTH); }
#undef EPJ_LOAD
        } else {
#pragma unroll
            for (int ai = 0; ai < 2; ++ai)
#pragma unroll
                for (int m = 0; m < 4; ++m) { const int row = row0 + ai * HALF + m * 16; bf16_t* rowp = P + (size_t)row * ldp + pn * BM + cl;
                    *(u32x4*)(rowp) = pack8(acc[ai][0][m][0], acc[ai][0][m][1]); *(u32x4*)(rowp + HALF) = pack8(acc[ai][1][m][0], acc[ai][1][m][1]); }
        }
    }
};
__device__ __forceinline__ u32x4 pair16(const u32x2 a, const u32x2 b) {
    auto rx = __builtin_amdgcn_permlane16_swap(a.x, b.x, false, false); auto ry = __builtin_amdgcn_permlane16_swap(a.y, b.y, false, false);
    u32x4 w; w.x = rx[0]; w.y = ry[0]; w.z = rx[1]; w.w = ry[1]; return w; }
struct EpiC8 {
    static constexpr bool PERM = true, AFTER_DRAIN = false;
    unsigned char* C8; unsigned char* krope; float* ssq_cq; float* ssq_ckv; const float* cosM; const float* sinM;
    __device__ __forceinline__ void operator()(const f32x4 (&acc_)[2][2][4][2], const Unit& u, int wr, int wc, int fr, int fq) const {
        const int row0 = u.pm * BM + wr * 64 + fr, cl = wc * 32 + 8 * fq, pn = u.pn; constexpr float inv = 1.0f / W8_SCALE;
        if (pn < 6) {
            float* ssq = pn >= 4 ? ssq_ckv : ssq_cq;
            u32x2 c8p[2] = {};
#pragma unroll
            for (int ai = 0; ai < 2; ++ai)
#pragma unroll
                for (int m = 0; m < 4; ++m) { const int row = row0 + ai * HALF + m * 16; const f32x4 a00 = acc_[ai][0][m][0] * inv, a01 = acc_[ai][0][m][1] * inv, a10 = acc_[ai][1][m][0] * inv, a11 = acc_[ai][1][m][1] * inv;
                    const u32x2 c0 = pack8_fp8(a00, a01), c1 = pack8_fp8(a10, a11);
                    if ((m & 1) == 0) { c8p[0] = c0; c8p[1] = c1; }
                    else { unsigned char* c8 = C8 + (size_t)(row - 16 + 16 * (fq & 1)) * 1536 + pn * BM + cl - 8 * (fq & 1); *(u32x4*)c8 = pair16(c8p[0], c0); *(u32x4*)(c8 + HALF) = pair16(c8p[1], c1); }
                    float s = (sumsq4(a00) + sumsq4(a01)) + (sumsq4(a10) + sumsq4(a11)); s = quad_row_sum(s);
                    if (fq == 0) atomic_add_f32(ssq + row, s); }
        } else if (wc == 0) {
            f32x4 acc[2][2][4][2]; u32x2 krp[2] = {};
#pragma unroll
            for (int ai = 0; ai < 2; ++ai)
#pragma unroll
                for (int bj = 0; bj < 2; ++bj)
#pragma unroll
                    for (int m = 0; m < 4; ++m) { acc[ai][bj][m][0] = acc_[ai][bj][m][0] * inv; acc[ai][bj][m][1] = acc_[ai][bj][m][1] * inv; }

#pragma unroll
            for (int ai = 0; ai < 2; ++ai)
#pragma unroll
                for (int m = 0; m < 4; ++m) { const int row = row0 + ai * HALF + m * 16, pos = row & 4095;
                    const float* cp = cosM + (size_t)pos * 32 + 8 * fq; const float* sp = sinM + (size_t)pos * 32 + 8 * fq;
                    f32x4 o1[2], o2[2];
#pragma unroll
                    for (int n = 0; n < 2; ++n) { const f32x4 c = *(const f32x4*)(cp + 4 * n), s = *(const f32x4*)(sp + 4 * n); const f32x4 x1 = acc[ai][0][m][n], x2 = acc[ai][1][m][n];
                        o1[n] = x1 * c - x2 * s; o2[n] = x2 * c + x1 * s; }
                    unsigned char* rowp = krope + (size_t)row * 64 + 8 * fq;
                    const u32x2 r1 = pack8_fp8(o1[0], o1[1]), r2 = pack8_fp8(o2[0], o2[1]);
                    if ((m & 1) == 0) { krp[0] = r1; krp[1] = r2; }
                    else { unsigned char* rp2 = krope + (size_t)(row - 16 + 16 * (fq & 1)) * 64 + 8 * fq - 8 * (fq & 1); *(u32x4*)rp2 = pair16(krp[0], r1); *(u32x4*)(rp2 + 32) = pair16(krp[1], r2); }
                    asm volatile("" ::: "memory"); }
        }
    }
};

struct EpiQ {
    static constexpr bool PERM = true, AFTER_DRAIN = false;
    unsigned char* Q; const float* ssq; const float* cosM; const float* sinM;
    __device__ __forceinline__ void operator()(const f32x4 (&acc)[2][2][4][2], const Unit& u, int wr, int wc, int fr, int fq) const {
        const int row0 = u.pm * BM + wr * 64 + fr, cl = wc * 32 + 8 * fq, pn = u.pn;
        float sqv[8];
#pragma unroll
        for (int g = 0; g < 8; ++g) sqv[g] = ssq[row0 + (g >> 2) * HALF + (g & 3) * 16];
        u32x2 qrp[2] = {};
        if (pn < 8) {
            const int odd = fq & 1;
#pragma unroll
            for (int ai = 0; ai < 2; ++ai)
#pragma unroll
                for (int mp = 0; mp < 2; ++mp) { const int m0 = 2 * mp, m1 = 2 * mp + 1;
                    const float rs0 = (1.0f / WQ8_SCALE) * __builtin_amdgcn_rsqf(sqv[ai * 4 + m0] * (1.0f / 1024.0f) + RMS_EPS), rs1 = (1.0f / WQ8_SCALE) * __builtin_amdgcn_rsqf(sqv[ai * 4 + m1] * (1.0f / 1024.0f) + RMS_EPS);
                    unsigned char* rowp = Q + (size_t)(row0 + ai * HALF + (m0 + odd) * 16) * 3072 + cl - 8 * odd;
#pragma unroll
                    for (int bj = 0; bj < 2; ++bj) *(u32x4*)(rowp + 192 * (2 * pn + bj)) = pair16(pack8_fp8(acc[ai][bj][m0][0] * rs0, acc[ai][bj][m0][1] * rs0), pack8_fp8(acc[ai][bj][m1][0] * rs1, acc[ai][bj][m1][1] * rs1));
                    asm volatile("" ::: "memory"); }
            return; }
#pragma unroll
        for (int ai = 0; ai < 2; ++ai)
#pragma unroll
            for (int m = 0; m < 4; ++m) { const int row = row0 + ai * HALF + m * 16; const float rs = (1.0f / WQ8_SCALE) * __builtin_amdgcn_rsqf(sqv[ai * 4 + m] * (1.0f / 1024.0f) + RMS_EPS);
                unsigned char* rowp = Q + (size_t)row * 3072;
                if (pn < 8) {
#pragma unroll
                    for (int bj = 0; bj < 2; ++bj) *(u32x2*)(rowp + 192 * (2 * pn + bj) + cl) = pack8_fp8(acc[ai][bj][m][0] * rs, acc[ai][bj][m][1] * rs);
                } else { const int pos = row & 4095, head = 4 * (pn - 8) + wc;
                    const float* cp = cosM + (size_t)pos * 32 + 8 * fq; const float* sp = sinM + (size_t)pos * 32 + 8 * fq;
                    f32x4 o1[2], o2[2];
#pragma unroll
                    for (int n = 0; n < 2; ++n) { const f32x4 c = *(const f32x4*)(cp + 4 * n) * rs, s = *(const f32x4*)(sp + 4 * n) * rs; const f32x4 x1 = acc[ai][0][m][n], x2 = acc[ai][1][m][n];
                        o1[n] = x1 * c - x2 * s; o2[n] = x2 * c + x1 * s; }
                    const u32x2 r1 = pack8_fp8(o1[0], o1[1]), r2 = pack8_fp8(o2[0], o2[1]);
                    if ((m & 1) == 0) { qrp[0] = r1; qrp[1] = r2; }
                    else { unsigned char* rp2 = Q + (size_t)(row - 16 + 16 * (fq & 1)) * 3072 + 192 * head + 128 + 8 * fq - 8 * (fq & 1); *(u32x4*)rp2 = pair16(qrp[0], r1); *(u32x4*)(rp2 + 32) = pair16(qrp[1], r2); } }
                asm volatile("" ::: "memory"); }
    }
};

struct EpiKV {
    static constexpr bool PERM = true, AFTER_DRAIN = false;
    unsigned char* K8; unsigned char* VT8; const float* ssq;
    static __device__ __forceinline__ unsigned quad_xpose(unsigned x, unsigned sel1, unsigned sel2) {
        const unsigned p1 = (unsigned)__builtin_amdgcn_update_dpp(0, (int)x, 0xB1, 0xf, 0xf, true);
        const unsigned y = __builtin_amdgcn_perm(p1, x, sel1);
        const unsigned p2 = (unsigned)__builtin_amdgcn_update_dpp(0, (int)y, 0x4E, 0xf, 0xf, true);
        return __builtin_amdgcn_perm(p2, y, sel2); }
    __device__ __forceinline__ void operator()(const f32x4 (&acc)[2][2][4][2], const Unit& u, int wr, int wc, int fr, int fq) const {
        const int row0 = u.pm * BM + wr * 64 + fr, cl = wc * 32 + 8 * fq, pn = u.pn;
        float sqv[8];
#pragma unroll
        for (int g = 0; g < 8; ++g) sqv[g] = ssq[row0 + (g >> 2) * HALF + (g & 3) * 16];
        const unsigned sel1 = (fr & 1) ? 0x03070105u : 0x06020400u, sel2 = (fr & 2) ? 0x03020706u : 0x05040100u;
        const bool up = (fr & 8) != 0;
        const int rowb = u.pm * BM + wr * 64;
        unsigned char* vbase = VT8 + ((size_t)(((rowb >> 12) * 16 + pn) * 128 + cl + (fr & 3)) << 12) + (rowb & 4095) + 32 * ((fr >> 2) & 1) + 8 * (fr >> 3);
#pragma unroll
        for (int ai = 0; ai < 2; ++ai)
#pragma unroll
            for (int m1 = 0; m1 < 2; ++m1) { unsigned dx[2], dy[2]; u32x2 kq[2];
#pragma unroll
                for (int m0 = 0; m0 < 2; ++m0) { const int m = 2 * m1 + m0, row = row0 + ai * HALF + m * 16; const float rs = (1.0f / WQ8_SCALE) * __builtin_amdgcn_rsqf(sqv[ai * 4 + m] * (1.0f / 512.0f) + RMS_EPS);
                    kq[m0] = pack8_fp8(acc[ai][0][m][0] * rs, acc[ai][0][m][1] * rs);
                    const u32x2 vw = pack8_fp8(acc[ai][1][m][0] * rs, acc[ai][1][m][1] * rs);
                    dx[m0] = quad_xpose(vw.x, sel1, sel2); dy[m0] = quad_xpose(vw.y, sel1, sel2); }
                const unsigned rx = (unsigned)__builtin_amdgcn_update_dpp(0, (int)(up ? dx[0] : dx[1]), 0x128, 0xf, 0xf, true);
                const unsigned ry = (unsigned)__builtin_amdgcn_update_dpp(0, (int)(up ? dy[0] : dy[1]), 0x128, 0xf, 0xf, true);
                u32x2 ox, oy; ox.x = up ? rx : dx[0]; ox.y = up ? dx[1] : rx; oy.x = up ? ry : dy[0]; oy.y = up ? dy[1] : ry;
                *(u32x4*)(K8 + (size_t)(row0 + ai * HALF + (2 * m1 + (fq & 1)) * 16) * 2048 + 128 * pn + cl - 8 * (fq & 1)) = pair16(kq[0], kq[1]);
                unsigned char* vp = vbase + ai * HALF + 16 * m1;
                *(u32x2*)vp = ox; *(u32x2*)(vp + ((size_t)4 << 12)) = oy; }
    }
};

template <bool BASE_BF16, int DEPTH = 4> struct EpiResT {
    static constexpr bool PERM = true, AFTER_DRAIN = false;
    const float* basef; bf16_t* HB; float* ssq; unsigned char* H8;
    __device__ __forceinline__ void operator()(const f32x4 (&acc)[2][2][4][2], const Unit& u, int wr, int wc, int fr, int fq) const {
        const int row0 = u.pm * BM + wr * 64 + fr, col0 = u.pn * BM + wc * 32 + 8 * fq;
        f32x4 b[8][4]; u32x4 bh[8][2]; u32x2 h8p[2] = {};
#define ER_LOAD(g_) do { const size_t off_ = (size_t)(row0 + ((g_) >> 2) * HALF + ((g_) & 3) * 16) * 4096 + col0; \
            if constexpr (BASE_BF16) { bh[g_][0] = *(const u32x4*)(HB + off_); bh[g_][1] = *(const u32x4*)(HB + off_ + HALF); } \
            else { b[g_][0] = *(const f32x4*)(basef + off_); b[g_][1] = *(const f32x4*)(basef + off_ + 4); b[g_][2] = *(const f32x4*)(basef + off_ + HALF); b[g_][3] = *(const f32x4*)(basef + off_ + HALF + 4); } } while (0)
#pragma unroll
        for (int g = 0; g < DEPTH; ++g) ER_LOAD(g);
#pragma unroll
        for (int g = 0; g < 8; ++g) { const int ai = g >> 2, m = g & 3, row = row0 + ai * HALF + m * 16; const size_t off = (size_t)row * 4096 + col0; float s = 0.f;
#pragma unroll
            for (int bj = 0; bj < 2; ++bj) { f32x4 b0, b1;
                if constexpr (BASE_BF16) { const u32x4 w = bh[g][bj]; b0 = (f32x4){bf_lo(w.x), bf_hi(w.x), bf_lo(w.y), bf_hi(w.y)}; b1 = (f32x4){bf_lo(w.z), bf_hi(w.z), bf_lo(w.w), bf_hi(w.w)}; }
                else { b0 = b[g][2 * bj]; b1 = b[g][2 * bj + 1]; }
                const f32x4 v0 = acc[ai][bj][m][0] + b0, v1 = acc[ai][bj][m][1] + b1;
                *(u32x4*)(HB + off + bj * HALF) = pack8(v0, v1);
                if (H8) { const u32x2 h8c = pack8_fp8(v0, v1);
                    if ((g & 1) == 0) h8p[bj] = h8c;
                    else *(u32x4*)(H8 + (size_t)(row - 16 + 16 * (fq & 1)) * 4096 + col0 - 8 * (fq & 1) + bj * HALF) = pair16(h8p[bj], h8c); }
                s += sumsq4(v0) + sumsq4(v1); }
            s = quad_row_sum(s); if (fq == 0) atomic_add_f32(ssq + row, s); asm volatile("" ::: "memory");
            if (g + DEPTH < 8) ER_LOAD(g + DEPTH); }
#undef ER_LOAD
    }
};


struct EpiPle {
    static constexpr bool PERM = true, AFTER_DRAIN = false;
    float* out; const bf16_t* HB; const bf16_t* PP; const float* ssq_in; float* ssq_out;
    __device__ __forceinline__ void operator()(const f32x4 (&acc)[2][2][4][2], const Unit& u, int wr, int wc, int fr, int fq) const {
        const int row0 = u.pm * BM + wr * 64 + fr, col0 = u.pn * BM + wc * 32 + 8 * fq;
#pragma unroll
        for (int ai = 0; ai < 2; ++ai)
#pragma unroll
            for (int m = 0; m < 4; ++m) { const int row = row0 + ai * HALF + m * 16; const size_t off = (size_t)row * 4096 + col0; float s = 0.f;
                const float nrs = (-1.4426950408889634f / W8_SCALE) * __builtin_amdgcn_rsqf(ssq_in[row] * (1.0f / 4096.0f) + RMS_EPS);
#pragma unroll
                for (int bj = 0; bj < 2; ++bj) { const u32x4 hw = *(const u32x4*)(HB + off + bj * HALF); const f32x4 b0 = (f32x4){bf_lo(hw.x), bf_hi(hw.x), bf_lo(hw.y), bf_hi(hw.y)}, b1 = (f32x4){bf_lo(hw.z), bf_hi(hw.z), bf_lo(hw.w), bf_hi(hw.w)}; const u32x4 pw = *(const u32x4*)(PP + off + bj * HALF);
                    f32x4 g0, g1;
#pragma unroll
                    for (int i = 0; i < 4; ++i) { g0[i] = __builtin_amdgcn_rcpf(1.0f + __builtin_amdgcn_exp2f(acc[ai][bj][m][0][i] * nrs)); g1[i] = __builtin_amdgcn_rcpf(1.0f + __builtin_amdgcn_exp2f(acc[ai][bj][m][1][i] * nrs)); }
                    const f32x4 p0 = (f32x4){bf_lo(pw.x), bf_hi(pw.x), bf_lo(pw.y), bf_hi(pw.y)}, p1 = (f32x4){bf_lo(pw.z), bf_hi(pw.z), bf_lo(pw.w), bf_hi(pw.w)};
                    const f32x4 v0 = b0 + g0 * p0, v1 = b1 + g1 * p1;
                    *(f32x4*)(out + off + bj * HALF) = v0; *(f32x4*)(out + off + bj * HALF + 4) = v1; s += sumsq4(v0) + sumsq4(v1); }
                s = quad_row_sum(s); if (fq == 0) atomic_add_f32(ssq_out + row, s); asm volatile("" ::: "memory"); }
    }
};

__device__ __forceinline__ float dpp_shr1z(float src) { return __int_as_float(__builtin_amdgcn_update_dpp(0, __float_as_int(src), 0x111, 0xf, 0xf, true)); }
__device__ __forceinline__ float dpp_shr2z(float src) { return __int_as_float(__builtin_amdgcn_update_dpp(0, __float_as_int(src), 0x112, 0xf, 0xf, true)); }
__device__ __forceinline__ float dpp_ror1(float src) { return __int_as_float(__builtin_amdgcn_update_dpp(0, __float_as_int(src), 0x121, 0xf, 0xf, true)); }
__device__ __forceinline__ float dpp_ror2(float src) { return __int_as_float(__builtin_amdgcn_update_dpp(0, __float_as_int(src), 0x122, 0xf, 0xf, true)); }
struct EpiGU {
    static constexpr bool PERM = true, AFTER_DRAIN = false;
    bf16_t* ACT; const float* ssq; const float* cw; const float* cb; float* GT; float* GH; float* UH;
    __device__ __forceinline__ void operator()(const f32x4 (&acc)[2][2][4][2], const Unit& u, int wr, int wc, int fr, int fq) const {
        const int row0 = u.pm * BM + wr * 64 + fr, f0 = u.pn * HALF + wc * 32 + 8 * fq;
        float sqv[8];
#pragma unroll
        for (int g = 0; g < 8; ++g) sqv[g] = ssq[row0 + (g >> 2) * HALF + (g & 3) * 16];
        f32x4 w0[2], w1[2], w2[2], bb[2], w0m[2], w1m[2];
#pragma unroll
        for (int n = 0; n < 2; ++n) { w0[n] = *(const f32x4*)(cw + f0 + 4 * n); w1[n] = *(const f32x4*)(cw + 11008 + f0 + 4 * n); w2[n] = *(const f32x4*)(cw + 22016 + f0 + 4 * n); bb[n] = *(const f32x4*)(cb + f0 + 4 * n);
            w1m[n] = (fr == 0) ? w1[n] : (f32x4){0.f, 0.f, 0.f, 0.f}; w0m[n] = (fr < 2) ? w0[n] : (f32x4){0.f, 0.f, 0.f, 0.f}; }
#pragma unroll
        for (int ai = 0; ai < 2; ++ai) {
            const int grp = (u.pm * BM + ai * HALF + wr * 64) >> 6;
            f32x4 pg[2] = {(f32x4){0.f, 0.f, 0.f, 0.f}, (f32x4){0.f, 0.f, 0.f, 0.f}};
#pragma unroll
            for (int m = 0; m < 4; ++m) { const int row = row0 + ai * HALF + m * 16; const float rs = __builtin_amdgcn_rsqf(sqv[ai * 4 + m] * (1.0f / 4096.0f) + RMS_EPS);
                f32x4 av[2];
#pragma unroll
                for (int n = 0; n < 2; ++n) { const f32x4 G = acc[ai][0][m][n] * rs, U = acc[ai][1][m][n] * rs; f32x4 r;
#pragma unroll
                    for (int i = 0; i < 4; ++i) { float a = bb[n][i] + w2[n][i] * G[i]; a += w1[n][i] * dpp_shr1z(G[i]); a += w0[n][i] * dpp_shr2z(G[i]);
                        if (m > 0) { a += w1m[n][i] * dpp_ror1(pg[n][i]); a += w0m[n][i] * dpp_ror2(pg[n][i]); }
                        r[i] = a * __builtin_amdgcn_rcpf(1.0f + __builtin_amdgcn_exp2f(-1.4426950408889634f * a)) * U[i]; }
                    av[n] = r; pg[n] = G;
                    if (m == 0 && fr < 2) { *(f32x4*)(GH + ((size_t)grp * 2 + fr) * 11008 + f0 + 4 * n) = G; *(f32x4*)(UH + ((size_t)grp * 2 + fr) * 11008 + f0 + 4 * n) = U; }
                    if (m == 3 && fr >= 14) *(f32x4*)(GT + ((size_t)grp * 2 + (fr - 14)) * 11008 + f0 + 4 * n) = G; }
                *(u32x4*)(ACT + (size_t)row * 11008 + f0) = pack8(av[0], av[1]); }
        }
    }
};

struct PanelOrder {
    int c;
    __device__ __forceinline__ bool next(int i, Unit& u) const { if (i >= 4) return false; const int x = c & 7, j = c >> 3; u.pm = 16 * i + 2 * x + (j >> 4); u.pn = j & 15; return true; }
    __device__ __forceinline__ void a_ready(const Unit&) const {}
    __device__ __forceinline__ void done(const Unit&) const {}
};
struct EpiPleFinal {
    static constexpr bool PERM = true, AFTER_DRAIN = false;
    float* out; const bf16_t* HB; const bf16_t* PP; const float* ssq_in; float* ssq3; unsigned* cnt; const float* gfin;
    __device__ __forceinline__ void operator()(const f32x4 (&acc)[2][2][4][2], const Unit& u, int wr, int wc, int fr, int fq) const {
        const int row0 = u.pm * BM + wr * 64 + fr, col0 = u.pn * BM + wc * 32 + 8 * fq;
        f32x4 h[2][2][4][2];
        constexpr int DEPTH = 4;
        u32x4 bh[8][2]; u32x4 pq[8][2]; float sq[8];
#define EP_LOAD(g_) do { const int row_ = row0 + ((g_) >> 2) * HALF + ((g_) & 3) * 16; const size_t off_ = (size_t)row_ * 4096 + col0; sq[g_] = ssq_in[row_]; \
            bh[g_][0] = *(const u32x4*)(HB + off_); bh[g_][1] = *(const u32x4*)(HB + off_ + HALF); \
            pq[g_][0] = *(const u32x4*)(PP + off_); pq[g_][1] = *(const u32x4*)(PP + off_ + HALF); } while (0)
#pragma unroll
        for (int g = 0; g < DEPTH; ++g) EP_LOAD(g);
#pragma unroll
        for (int g = 0; g < 8; ++g) { const int ai = g >> 2, m = g & 3, row = row0 + ai * HALF + m * 16; float s = 0.f;
            const float nrs = (-1.4426950408889634f / W8_SCALE) * __builtin_amdgcn_rsqf(sq[g] * (1.0f / 4096.0f) + RMS_EPS);
#pragma unroll
            for (int bj = 0; bj < 2; ++bj) { const u32x4 pw = pq[g][bj];
                f32x4 g0, g1;
#pragma unroll
                for (int i = 0; i < 4; ++i) { g0[i] = __builtin_amdgcn_rcpf(1.0f + __builtin_amdgcn_exp2f(acc[ai][bj][m][0][i] * nrs)); g1[i] = __builtin_amdgcn_rcpf(1.0f + __builtin_amdgcn_exp2f(acc[ai][bj][m][1][i] * nrs)); }
                const f32x4 p0 = (f32x4){bf_lo(pw.x), bf_hi(pw.x), bf_lo(pw.y), bf_hi(pw.y)}, p1 = (f32x4){bf_lo(pw.z), bf_hi(pw.z), bf_lo(pw.w), bf_hi(pw.w)};
                const u32x4 hw = bh[g][bj]; const f32x4 b0 = (f32x4){bf_lo(hw.x), bf_hi(hw.x), bf_lo(hw.y), bf_hi(hw.y)}, b1 = (f32x4){bf_lo(hw.z), bf_hi(hw.z), bf_lo(hw.w), bf_hi(hw.w)};
                const f32x4 v0 = b0 + g0 * p0, v1 = b1 + g1 * p1;
                h[ai][bj][m][0] = v0; h[ai][bj][m][1] = v1; s += sumsq4(v0) + sumsq4(v1); }
            s = quad_row_sum(s); if (fq == 0) atomic_add_f32(ssq3 + row, s); asm volatile("" ::: "memory");
            if (g + DEPTH < 8) EP_LOAD(g + DEPTH); }
#undef EP_LOAD
        asm volatile("s_waitcnt vmcnt(0)" ::: "memory");
        unsigned* cw = cnt + 64 * u.pm;
        if ((threadIdx.x & 63) == 0) __hip_atomic_fetch_add(cw, 1u, __ATOMIC_RELAXED, __HIP_MEMORY_SCOPE_AGENT);
        if (threadIdx.x < 64) { unsigned spins = 0;
            while ((unsigned)__builtin_amdgcn_readfirstlane(__hip_atomic_load(cw, __ATOMIC_RELAXED, __HIP_MEMORY_SCOPE_AGENT)) < 128u) { __builtin_amdgcn_s_sleep(2); if (++spins > (1u << 22)) break; }
            asm volatile("s_waitcnt vmcnt(0)" ::: "memory"); }
        asm volatile("" ::: "memory"); __builtin_amdgcn_s_barrier(); asm volatile("" ::: "memory");
        float s3[8]; f32x4 gf[2][2];
#pragma unroll
        for (int g = 0; g < 8; ++g) s3[g] = __hip_atomic_load(ssq3 + row0 + (g >> 2) * HALF + (g & 3) * 16, __ATOMIC_RELAXED, __HIP_MEMORY_SCOPE_AGENT);
#pragma unroll
        for (int bj = 0; bj < 2; ++bj) { gf[bj][0] = *(const f32x4*)(gfin + col0 + bj * HALF); gf[bj][1] = *(const f32x4*)(gfin + col0 + bj * HALF + 4); }
#pragma unroll
        for (int ai = 0; ai < 2; ++ai)
#pragma unroll
            for (int m = 0; m < 4; ++m) { const int row = row0 + ai * HALF + m * 16; const size_t off = (size_t)row * 4096 + col0;
                const float rs = __builtin_amdgcn_rsqf(s3[ai * 4 + m] * (1.0f / 4096.0f) + RMS_EPS);
#pragma unroll
                for (int bj = 0; bj < 2; ++bj) { *(f32x4*)(out + off + bj * HALF) = h[ai][bj][m][0] * (gf[bj][0] * rs); *(f32x4*)(out + off + bj * HALF + 4) = h[ai][bj][m][1] * (gf[bj][1] * rs); } }
    }
};
template <class Epi, class Sched, bool ALIGN_EPI = false, bool SP2 = false>
__device__ __forceinline__ void gemm_phase(PG8_LAS unsigned char* lds, const Gemm g, const Sched& S, const Epi& E) {
    const int tid = threadIdx.x, wid = __builtin_amdgcn_readfirstlane(tid >> 6), lane = tid & 63, wr = wid >> 2, wc = wid & 3, fr = lane & 15, fq = lane >> 4;
    int K = g.K; asm volatile("" : "+s"(K));
    const int nt = K / BK;
    unsigned voffA[2], voffB[2];
#pragma unroll
    for (int i = 0; i < 2; ++i) { int R, C; stage_rc(tid * 16 + i * 8192, R, C); const int Rb = Epi::PERM ? ((R & ~31) + perm32(R & 31)) : R;
        voffA[i] = (unsigned)(R * g.lda + C) * 2u; voffB[i] = (unsigned)(Rb * g.ldb + C) * 2u; }
    const size_t kstep = (size_t)(BK * 2);
    const size_t hstepA = (size_t)HALF * g.lda * 2, hstepB = (size_t)HALF * g.ldb * 2;
    const size_t tstepA = 2 * hstepA, tstepB = 2 * hstepB;
    const unsigned ldsw = (unsigned)wid * 1024u;
    const int aoff = lds_byte(wr * 64 + fr, fq * 8), boff = lds_byte(wc * 32 + fr, fq * 8);
#define PG8_SA(b, h) (((b) * 2 + (h)) * HTB)
#define PG8_SB(b, h) ((4 + (b) * 2 + (h)) * HTB)
#ifndef PG8_B_AUX
#define PG8_B_AUX 0
#endif
#define PG8_STAGE(bufoff, gbase, voff) do { _Pragma("unroll") for (int _i = 0; _i < 2; ++_i) { \
        if ((bufoff) >= 4 * HTB) __builtin_amdgcn_global_load_lds((const unsigned*)((const char*)(gbase) + (voff)[_i]), (PG8_LAS unsigned*)(lds + (bufoff) + ldsw + _i * 8192), 16, 0, PG8_B_AUX); \
        else __builtin_amdgcn_global_load_lds((const unsigned*)((const char*)(gbase) + (voff)[_i]), (PG8_LAS unsigned*)(lds + (bufoff) + ldsw + _i * 8192), 16, 0, 0); } } while (0)
#define PG8_LDA(dst, b, h) do { _Pragma("unroll") for (int m = 0; m < 4; ++m) _Pragma("unroll") for (int k = 0; k < 2; ++k) dst[m][k] = *(const PG8_LAS bf16x8*)(lds + PG8_SA(b, h) + aoff + m * 2048 + k * 1024); } while (0)
#define PG8_LDB(dst, b, h) do { _Pragma("unroll") for (int n = 0; n < 2; ++n) _Pragma("unroll") for (int k = 0; k < 2; ++k) dst[n][k] = *(const PG8_LAS bf16x8*)(lds + PG8_SB(b, h) + boff + n * 2048 + k * 1024); } while (0)
#define PG8_MMA(ai, bj, At, Bt) do { __builtin_amdgcn_s_setprio(1); _Pragma("unroll") for (int m = 0; m < 4; ++m) _Pragma("unroll") for (int n = 0; n < 2; ++n) _Pragma("unroll") for (int k = 0; k < 2; ++k) \
        acc[ai][bj][m][n] = __builtin_amdgcn_mfma_f32_16x16x32_bf16(Bt[n][k], At[m][k], acc[ai][bj][m][n], 0, 0, 0); __builtin_amdgcn_s_setprio(0); } while (0)
#define PG8_WAIT_V(n) asm volatile("s_waitcnt vmcnt(" #n ")" ::: "memory")
#define PG8_WAIT_L(n) asm volatile("s_waitcnt lgkmcnt(" #n ")" ::: "memory")
#define PG8_BAR __builtin_amdgcn_s_barrier()
#define PG8_SCHED __builtin_amdgcn_sched_barrier(0)
    Unit cur, nxt; int ui = 0;
    if (!S.next(0, cur)) return;
    f32x4 acc[2][2][4][2];
#pragma unroll
    for (int a = 0; a < 2; ++a)
#pragma unroll
        for (int b = 0; b < 2; ++b)
#pragma unroll
            for (int m = 0; m < 4; ++m)
#pragma unroll
                for (int n = 0; n < 2; ++n) acc[a][b][m][n] = (f32x4){0.f, 0.f, 0.f, 0.f};
    bf16x8 At[4][2], B0[2][2], B1[2][2];
    const char* cA = (const char*)g.A + (size_t)cur.pm * tstepA; const char* cB = (const char*)g.Bt + (size_t)cur.pn * tstepB;
    S.a_ready(cur);
    if constexpr (SP2) {
        PG8_STAGE(PG8_SB(0, 0), cB, voffB); PG8_STAGE(PG8_SB(0, 1), cB + hstepB, voffB); PG8_STAGE(PG8_SA(0, 0), cA, voffA); PG8_STAGE(PG8_SA(0, 1), cA + hstepA, voffA);
        if (wr == 1) PG8_BAR;
        PG8_WAIT_V(2); PG8_BAR;
        PG8_STAGE(PG8_SB(1, 0), cB + kstep, voffB); PG8_STAGE(PG8_SA(1, 0), cA + kstep, voffA); PG8_STAGE(PG8_SB(1, 1), cB + hstepB + kstep, voffB);
        PG8_WAIT_V(6); PG8_BAR;
    } else {
        PG8_STAGE(PG8_SB(0, 0), cB, voffB); PG8_STAGE(PG8_SA(0, 0), cA, voffA); PG8_STAGE(PG8_SB(0, 1), cB + hstepB, voffB); PG8_STAGE(PG8_SA(0, 1), cA + hstepA, voffA);
        if (wr == 1) PG8_BAR;
        PG8_WAIT_V(4); PG8_BAR;
        PG8_STAGE(PG8_SB(1, 0), cB + kstep, voffB); PG8_STAGE(PG8_SA(1, 0), cA + kstep, voffA); PG8_STAGE(PG8_SB(1, 1), cB + hstepB + kstep, voffB);
        PG8_WAIT_V(6); PG8_BAR;
    }
    for (;;) {
        const bool has_next = S.next(ui + 1, nxt);
        const char* nA = has_next ? (const char*)g.A + (size_t)nxt.pm * tstepA : cA; const char* nB = has_next ? (const char*)g.Bt + (size_t)nxt.pn * tstepB : cB;
        for (int t = 0; t < nt; t += 2) {
            const bool last = (t == nt - 2);
            const char* a1 = cA + (size_t)(t + 1) * kstep;
            const char* a2 = last ? nA : cA + (size_t)(t + 2) * kstep; const char* b2 = last ? nB : cB + (size_t)(t + 2) * kstep;
            const char* a3 = a2 + kstep; const char* b3 = b2 + kstep;
            if (last && has_next) S.a_ready(nxt);
            if constexpr (SP2) {
            PG8_LDB(B0, 0, 0); PG8_LDB(B1, 0, 1); PG8_SCHED; PG8_LDA(At, 0, 0); PG8_STAGE(PG8_SA(1, 1), a1 + hstepA, voffA);
            PG8_WAIT_V(8); PG8_WAIT_L(0); PG8_BAR; PG8_MMA(0, 0, At, B0); PG8_MMA(0, 1, At, B1); PG8_BAR; PG8_SCHED;
            PG8_LDA(At, 0, 1); PG8_STAGE(PG8_SB(0, 0), b2, voffB); PG8_STAGE(PG8_SB(0, 1), b2 + hstepB, voffB); PG8_STAGE(PG8_SA(0, 0), a2, voffA);
            PG8_WAIT_V(8); PG8_WAIT_L(0); PG8_BAR; PG8_MMA(1, 0, At, B0); PG8_MMA(1, 1, At, B1); PG8_BAR; PG8_SCHED;
            PG8_LDB(B0, 1, 0); PG8_LDB(B1, 1, 1); PG8_SCHED; PG8_LDA(At, 1, 0); PG8_STAGE(PG8_SA(0, 1), a2 + hstepA, voffA);
            PG8_WAIT_V(8); PG8_WAIT_L(0); PG8_BAR; PG8_MMA(0, 0, At, B0); PG8_MMA(0, 1, At, B1); PG8_BAR; PG8_SCHED;
            PG8_LDA(At, 1, 1); PG8_STAGE(PG8_SB(1, 0), b3, voffB); PG8_STAGE(PG8_SB(1, 1), b3 + hstepB, voffB); PG8_STAGE(PG8_SA(1, 0), a3, voffA);
            PG8_WAIT_V(8); PG8_WAIT_L(0); PG8_BAR; PG8_MMA(1, 0, At, B0); PG8_MMA(1, 1, At, B1); PG8_BAR; PG8_SCHED;
            } else {
            PG8_LDB(B0, 0, 0); PG8_SCHED; PG8_LDA(At, 0, 0); PG8_STAGE(PG8_SA(1, 1), a1 + hstepA, voffA);
            PG8_WAIT_L(8); PG8_BAR; PG8_WAIT_L(0); PG8_MMA(0, 0, At, B0); PG8_BAR; PG8_SCHED;
            PG8_LDB(B1, 0, 1); PG8_STAGE(PG8_SB(0, 0), b2, voffB);
            PG8_BAR; PG8_WAIT_L(0); PG8_MMA(0, 1, At, B1); PG8_BAR;
            PG8_LDA(At, 0, 1); PG8_STAGE(PG8_SA(0, 0), a2, voffA);
            PG8_BAR; PG8_WAIT_L(0); PG8_MMA(1, 0, At, B0); PG8_BAR; PG8_SCHED;
            PG8_STAGE(PG8_SB(0, 1), b2 + hstepB, voffB);
            PG8_WAIT_V(6); PG8_BAR; PG8_MMA(1, 1, At, B1); PG8_BAR;
            PG8_LDB(B0, 1, 0); PG8_SCHED; PG8_LDA(At, 1, 0); PG8_STAGE(PG8_SA(0, 1), a2 + hstepA, voffA);
            PG8_WAIT_L(8); PG8_BAR; PG8_WAIT_L(0); PG8_MMA(0, 0, At, B0); PG8_BAR; PG8_SCHED;
            PG8_LDB(B1, 1, 1); PG8_STAGE(PG8_SB(1, 0), b3, voffB);
            PG8_BAR; PG8_WAIT_L(0); PG8_MMA(0, 1, At, B1); PG8_BAR;
            PG8_LDA(At, 1, 1); PG8_STAGE(PG8_SA(1, 0), a3, voffA);
            PG8_BAR; PG8_WAIT_L(0); PG8_MMA(1, 0, At, B0); PG8_BAR; PG8_SCHED;
            PG8_STAGE(PG8_SB(1, 1), b3 + hstepB, voffB);
            PG8_WAIT_V(6); PG8_BAR; PG8_MMA(1, 1, At, B1); PG8_BAR;
            }
        }
        if constexpr (ALIGN_EPI) { if (wr == 0) PG8_BAR; }
        if constexpr (!Epi::AFTER_DRAIN) { E(acc, cur, wr, wc, fr, fq); S.done(cur); }
        if (!has_next) break;
#pragma unroll
        for (int a = 0; a < 2; ++a)
#pragma unroll
            for (int b = 0; b < 2; ++b)
#pragma unroll
                for (int m = 0; m < 4; ++m)
#pragma unroll
                    for (int n = 0; n < 2; ++n) acc[a][b][m][n] = (f32x4){0.f, 0.f, 0.f, 0.f};
        cur = nxt; cA = nA; cB = nB; ++ui;
        if constexpr (ALIGN_EPI) { if (wr == 1) PG8_BAR; }
    }
    PG8_WAIT_V(0);
    if constexpr (!ALIGN_EPI) { if (wr == 0) PG8_BAR; }
    PG8_BAR;
    if constexpr (Epi::AFTER_DRAIN) { E.fused(acc, cur, wr, wc, fr, fq, lds, wid, lane); S.done(cur); }
#undef PG8_SA
#undef PG8_SB
#undef PG8_STAGE
#undef PG8_LDA
#undef PG8_LDB
#undef PG8_MMA
#undef PG8_WAIT_V
#undef PG8_WAIT_L
#undef PG8_BAR
#undef PG8_SCHED
}
struct Gemm8 { const unsigned char* A; const unsigned char* Bt; int M, N, K, lda, ldb; };
typedef int v8i32 __attribute__((ext_vector_type(8)));
typedef int v4i32 __attribute__((ext_vector_type(4)));
template <class Epi, class Sched, bool ALIGN_EPI = true, int NTB = 0, int WSC = 0x7f7f7f7f, int ASC = 0x7f7f7f7f>
__device__ __forceinline__ void gemm_phase8(PG8_LAS unsigned char* lds, const Gemm8 g, const Sched& S, const Epi& E) {
    constexpr bool SP2 = true;
    const int tid = threadIdx.x, wid = __builtin_amdgcn_readfirstlane(tid >> 6), lane = tid & 63, wr = wid >> 2, wc = wid & 3, fr = lane & 15, fq = lane >> 4;
    int K = g.K; asm volatile("" : "+s"(K));
    const int nt = K / 128;
    unsigned voffA[2], voffB[2];
#pragma unroll
    for (int i = 0; i < 2; ++i) { int R, C; stage_rc(tid * 16 + i * 8192, R, C); const int Rb = Epi::PERM ? ((R & ~31) + perm32(R & 31)) : R;
        voffA[i] = (unsigned)(R * g.lda + 2 * C); voffB[i] = (unsigned)(Rb * g.ldb + 2 * C); }
    const size_t kstep = (size_t)(BK * 2);
    const size_t hstepA = (size_t)HALF * g.lda, hstepB = (size_t)HALF * g.ldb;
    const size_t tstepA = 2 * hstepA, tstepB = 2 * hstepB;
    const unsigned ldsw = (unsigned)wid * 1024u;
    const int aoffb = lds_byte(wr * 64 + fr, fq * 8), boffb = lds_byte(wc * 32 + fr, fq * 8);
    const int aoff0 = lds_byte(wr * 64 + fr, 16 * fq), aoff1 = lds_byte(wr * 64 + fr, 16 * fq + 8), boff0 = lds_byte(wc * 32 + fr, 16 * fq), boff1 = lds_byte(wc * 32 + fr, 16 * fq + 8);
#define PG8_SA(b, h) (((b) * 2 + (h)) * HTB)
#define PG8_SB(b, h) ((4 + (b) * 2 + (h)) * HTB)
#define PG8_STAGE(bufoff, gbase, voff) do { _Pragma("unroll") for (int _i = 0; _i < 2; ++_i) \
        __builtin_amdgcn_global_load_lds((const unsigned*)((const char*)(gbase) + (voff)[_i]), (PG8_LAS unsigned*)(lds + (bufoff) + ldsw + _i * 8192), 16, 0, 0); } while (0)
#define PG8_LDA(dst, b, h) do { const int o0_ = isb ? aoffb : aoff0, o1_ = isb ? aoffb + 1024 : aoff1; _Pragma("unroll") for (int m = 0; m < 4; ++m) { dst[m].lo = *(const PG8_LAS v4i32*)(lds + PG8_SA(b, h) + o0_ + m * 2048); dst[m].hi = *(const PG8_LAS v4i32*)(lds + PG8_SA(b, h) + o1_ + m * 2048); } } while (0)
#define PG8_LDB(dst, b, h) do { const int o0_ = isb ? boffb : boff0, o1_ = isb ? boffb + 1024 : boff1; _Pragma("unroll") for (int n = 0; n < 2; ++n) { dst[n].lo = *(const PG8_LAS v4i32*)(lds + PG8_SB(b, h) + o0_ + n * 2048); dst[n].hi = *(const PG8_LAS v4i32*)(lds + PG8_SB(b, h) + o1_ + n * 2048); } } while (0)
#define PG8_MMA(ai, bj, At, Bt) do { __builtin_amdgcn_s_setprio(1); \
        if (NTB > 0 && isb) { _Pragma("unroll") for (int m = 0; m < 4; ++m) _Pragma("unroll") for (int n = 0; n < 2; ++n) asm volatile("v_mfma_f32_16x16x32_bf16 %0, %1, %2, %0" : "+v"(acc[ai][bj][m][n]) : "v"(Bt[n].lo), "v"(At[m].lo)); \
            _Pragma("unroll") for (int m = 0; m < 4; ++m) _Pragma("unroll") for (int n = 0; n < 2; ++n) asm volatile("v_mfma_f32_16x16x32_bf16 %0, %1, %2, %0" : "+v"(acc[ai][bj][m][n]) : "v"(Bt[n].hi), "v"(At[m].hi)); } \
        else { _Pragma("unroll") for (int m = 0; m < 4; ++m) _Pragma("unroll") for (int n = 0; n < 2; ++n) \
            asm volatile("v_mfma_scale_f32_16x16x128_f8f6f4 %0, %1, %2, %0, %3, %4 op_sel_hi:[0,0,0]" : "+v"(acc[ai][bj][m][n]) : "v"(Bt[n]), "v"(At[m]), "v"(w_scale), "v"(a_scale)); } \
        __builtin_amdgcn_s_setprio(0); } while (0)
#define PG8_MFMA_DRAIN() asm volatile("s_nop 15\n\ts_nop 15\n\ts_nop 15\n\ts_nop 15\n\ts_nop 15\n\ts_nop 15" ::: "memory")
#define PG8_WAIT_V(n) asm volatile("s_waitcnt vmcnt(" #n ")" ::: "memory")
#define PG8_WAIT_L(n) asm volatile("s_waitcnt lgkmcnt(" #n ")" ::: "memory")
#define PG8_BAR __builtin_amdgcn_s_barrier()
#define PG8_SCHED __builtin_amdgcn_sched_barrier(0)
    Unit cur, nxt; int ui = 0;
    if (!S.next(0, cur)) return;
    f32x4 acc[2][2][4][2];
#pragma unroll
    for (int a = 0; a < 2; ++a)
#pragma unroll
        for (int b = 0; b < 2; ++b)
#pragma unroll
            for (int m = 0; m < 4; ++m)
#pragma unroll
                for (int n = 0; n < 2; ++n) acc[a][b][m][n] = (f32x4){0.f, 0.f, 0.f, 0.f};
    v8i32 At[4], B0[2], B1[2]; const int w_scale = WSC, a_scale = ASC;
    const char* cA = (const char*)g.A + (size_t)cur.pm * tstepA; const char* cB = (const char*)g.Bt + (size_t)cur.pn * tstepB;
    S.a_ready(cur);
    if constexpr (SP2) {
        PG8_STAGE(PG8_SB(0, 0), cB, voffB); PG8_STAGE(PG8_SB(0, 1), cB + hstepB, voffB); PG8_STAGE(PG8_SA(0, 0), cA, voffA); PG8_STAGE(PG8_SA(0, 1), cA + hstepA, voffA);
        if (wr == 1) PG8_BAR;
        PG8_WAIT_V(2); PG8_BAR;
        PG8_STAGE(PG8_SB(1, 0), cB + kstep, voffB); PG8_STAGE(PG8_SA(1, 0), cA + kstep, voffA); PG8_STAGE(PG8_SB(1, 1), cB + hstepB + kstep, voffB);
        PG8_WAIT_V(6); PG8_BAR;
    } else {
        PG8_STAGE(PG8_SB(0, 0), cB, voffB); PG8_STAGE(PG8_SA(0, 0), cA, voffA); PG8_STAGE(PG8_SB(0, 1), cB + hstepB, voffB); PG8_STAGE(PG8_SA(0, 1), cA + hstepA, voffA);
        if (wr == 1) PG8_BAR;
        PG8_WAIT_V(4); PG8_BAR;
        PG8_STAGE(PG8_SB(1, 0), cB + kstep, voffB); PG8_STAGE(PG8_SA(1, 0), cA + kstep, voffA); PG8_STAGE(PG8_SB(1, 1), cB + hstepB + kstep, voffB);
        PG8_WAIT_V(6); PG8_BAR;
    }
#define PG8_KSTEP(ISB) do { constexpr bool isb = ISB; const bool last = (t == nt - 2); \
            const char* a1 = cA + (size_t)(t + 1) * kstep; \
            const char* a2 = last ? nA : cA + (size_t)(t + 2) * kstep; const char* b2 = last ? nB : cB + (size_t)(t + 2) * kstep; \
            const char* a3 = a2 + kstep; const char* b3 = b2 + kstep; \
            if (last && has_next) S.a_ready(nxt); \
            PG8_LDB(B0, 0, 0); PG8_LDB(B1, 0, 1); PG8_SCHED; PG8_LDA(At, 0, 0); PG8_STAGE(PG8_SA(1, 1), a1 + hstepA, voffA); \
            PG8_WAIT_V(8); PG8_WAIT_L(0); PG8_BAR; PG8_MMA(0, 0, At, B0); PG8_MMA(0, 1, At, B1); PG8_BAR; PG8_SCHED; \
            PG8_LDA(At, 0, 1); PG8_STAGE(PG8_SB(0, 0), b2, voffB); PG8_STAGE(PG8_SB(0, 1), b2 + hstepB, voffB); PG8_STAGE(PG8_SA(0, 0), a2, voffA); \
            PG8_WAIT_V(8); PG8_WAIT_L(0); PG8_BAR; PG8_MMA(1, 0, At, B0); PG8_MMA(1, 1, At, B1); PG8_BAR; PG8_SCHED; \
            PG8_LDB(B0, 1, 0); PG8_LDB(B1, 1, 1); PG8_SCHED; PG8_LDA(At, 1, 0); PG8_STAGE(PG8_SA(0, 1), a2 + hstepA, voffA); \
            PG8_WAIT_V(8); PG8_WAIT_L(0); PG8_BAR; PG8_MMA(0, 0, At, B0); PG8_MMA(0, 1, At, B1); PG8_BAR; PG8_SCHED; \
            PG8_LDA(At, 1, 1); PG8_STAGE(PG8_SB(1, 0), b3, voffB); PG8_STAGE(PG8_SB(1, 1), b3 + hstepB, voffB); PG8_STAGE(PG8_SA(1, 0), a3, voffA); \
            PG8_WAIT_V(8); PG8_WAIT_L(0); PG8_BAR; PG8_MMA(1, 0, At, B0); PG8_MMA(1, 1, At, B1); PG8_BAR; PG8_SCHED; } while (0)
    for (;;) {
        const bool has_next = S.next(ui + 1, nxt);
        const char* nA = has_next ? (const char*)g.A + (size_t)nxt.pm * tstepA : cA; const char* nB = has_next ? (const char*)g.Bt + (size_t)nxt.pn * tstepB : cB;
        { int t = 0;
          if constexpr (NTB > 0) { for (; t < NTB; t += 2) PG8_KSTEP(true); }
          for (; t < nt; t += 2) PG8_KSTEP(false); }
        if constexpr (ALIGN_EPI) { if (wr == 0) PG8_BAR; }
        PG8_MFMA_DRAIN();
        if constexpr (!Epi::AFTER_DRAIN) { E(acc, cur, wr, wc, fr, fq); S.done(cur); }
        if (!has_next) break;
#pragma unroll
        for (int a = 0; a < 2; ++a)
#pragma unroll
            for (int b = 0; b < 2; ++b)
#pragma unroll
                for (int m = 0; m < 4; ++m)
#pragma unroll
                    for (int n = 0; n < 2; ++n) acc[a][b][m][n] = (f32x4){0.f, 0.f, 0.f, 0.f};
        cur = nxt; cA = nA; cB = nB; ++ui;
        if constexpr (ALIGN_EPI) { if (wr == 1) PG8_BAR; }
    }
    PG8_WAIT_V(0);
    if constexpr (!ALIGN_EPI) { if (wr == 0) PG8_BAR; }
    PG8_BAR;
    if constexpr (Epi::AFTER_DRAIN) { E.fused(acc, cur, wr, wc, fr, fq, lds, wid, lane); S.done(cur); }
#undef PG8_SA
#undef PG8_SB
#undef PG8_STAGE
#undef PG8_LDA
#undef PG8_LDB
#undef PG8_MMA
#undef PG8_KSTEP
#undef PG8_MFMA_DRAIN
#undef PG8_WAIT_V
#undef PG8_WAIT_L
#undef PG8_BAR
#undef PG8_SCHED
}
}

constexpr int NWAVES = 8;
constexpr int NB = 4, SEQ = 4096, M = NB * SEQ, DM = 4096, NFF = 11008, LDP = 9984  ;
constexpr int NGRP = M / 64;
constexpr size_t MiB = 1u << 20;
constexpr size_t WS_CTL = 0, CTL_ZERO_BYTES = 1 * MiB;
constexpr int CW_BAR = 4096;
constexpr size_t CTL_SSQ = 256 * 1024;
constexpr size_t CTL_PCNT = 64 * 1024;
constexpr size_t WS_COSM = 1 * MiB + 512 * 1024, WS_SINM = 2 * MiB, WS_COSR = 3 * MiB, WS_SINR = 5 * MiB;
constexpr size_t WS_PB = 8 * MiB;
constexpr size_t WS_KR = 16 * MiB;
constexpr size_t WS_STATS = 18 * MiB;
constexpr size_t WS_WIN = 32 * MiB, WS_WUQ = 110 * MiB, WS_WUKV = 116 * MiB, WS_WO = 120 * MiB, WS_WGU = 152 * MiB;
constexpr size_t WS_PP = 18 * MiB;
constexpr size_t WS_XB = 324 * MiB;
constexpr size_t WS_WDN = 324 * MiB, WS_WPG = 410 * MiB, WS_WPP = 1016 * MiB;
constexpr size_t WS_PROJ = 452 * MiB;
constexpr size_t WS_HB = 452 * MiB;
constexpr size_t WS_ACT = 580 * MiB;
constexpr size_t WS_Q = 764 * MiB, WS_KB = 860 * MiB, WS_VB = 924 * MiB;
constexpr size_t WS_GT = 924 * MiB, WS_GH = 946 * MiB, WS_UH = 968 * MiB;
constexpr size_t WS_H8 = 924 * MiB;
constexpr size_t WS_WIN8 = 96 * MiB;
constexpr size_t WS_XB8 = 764 * MiB;
constexpr size_t WS_C8 = 992 * MiB;
constexpr size_t WS_END = 1018 * MiB;
static_assert(WS_ACT + (size_t)M * NFF * 2 <= WS_GT && WS_UH + (size_t)NGRP * 2 * NFF * 4 <= WS_END && WS_WGU + (size_t)22016 * 4096 * 2 <= WS_XB && WS_PROJ + (size_t)M * LDP * 2 <= WS_Q, "d_ws map");

constexpr int CCP = 3072;
constexpr float MO8_SCALE = 16.0f;
constexpr int RING_BYTES = 131072, LDSCTL_OFF = RING_BYTES, MISC_OFF = LDSCTL_OFF + 320, LDS_BYTES = 147456;

#define GAS __attribute__((address_space(1)))
#define LAS __attribute__((address_space(3)))
typedef unsigned short bf16;
typedef unsigned v4u __attribute__((ext_vector_type(4)));
typedef unsigned v2u __attribute__((ext_vector_type(2)));
typedef float f32x4 __attribute__((ext_vector_type(4)));
typedef float f32x16 __attribute__((ext_vector_type(16)));
typedef short bf16x8 __attribute__((ext_vector_type(8)));
typedef short s16x4 __attribute__((ext_vector_type(4)));
typedef GAS unsigned gu32;
#define RLX_AGENT __ATOMIC_RELAXED, __HIP_MEMORY_SCOPE_AGENT
#define LDS_WAIT() asm volatile("s_waitcnt lgkmcnt(0)" ::: "memory")
#define VM_WAIT() asm volatile("s_waitcnt vmcnt(0)" ::: "memory")
#define SBAR() __builtin_amdgcn_sched_barrier(0)
__device__ __forceinline__ unsigned cvtpk(float lo, float hi) { return pg8::cvt_pk_bf16(lo, hi); }
__device__ __forceinline__ float bflo(unsigned w) { return __uint_as_float(w << 16); }
__device__ __forceinline__ float bfhi(unsigned w) { return __uint_as_float(w & 0xffff0000u); }
__device__ __forceinline__ int crow(int r, int hi) { return (r & 3) + 8 * (r >> 2) + 4 * hi; }
__device__ __forceinline__ s16x4 tr_read(const LAS unsigned char* p) { typedef short v4i16_t __attribute__((ext_vector_type(4))); return __builtin_bit_cast(s16x4, __builtin_amdgcn_ds_read_tr16_b64_v4i16((LAS v4i16_t*)p)); }
typedef __amdgpu_buffer_rsrc_t rsrc_t;
__device__ __forceinline__ rsrc_t make_rsrc(const void* p) { return __builtin_amdgcn_make_buffer_rsrc((void*)p, 0, 0x7fffffff, 0x00020000); }
__device__ __forceinline__ v4u bufld16(rsrc_t r, unsigned voff, unsigned soff) { return __builtin_bit_cast(v4u, __builtin_amdgcn_raw_buffer_load_b128(r, (int)voff, (int)soff, 0)); }
__device__ __forceinline__ void bufst16(rsrc_t r, unsigned voff, unsigned soff, v4u v) { __builtin_amdgcn_raw_buffer_store_b128(v, r, (int)voff, (int)soff, 0); }
#define XB_TMO      128
#define XB_XCNT(j)  (256  + 64 * (j))
#define XB_XSUB(j)  (1280 + 64 * (j))
#define XB_XGEN(j)  (2304 + 64 * (j))
#define XB_TOP      3328
#define XB_TOPGEN   3392
#define XCD_BAR_WORDS 3456
#define XB_SPIN_CAP (1u << 18)

__device__ __forceinline__ unsigned xb_ld(unsigned* p)              { return __hip_atomic_load(p, __ATOMIC_RELAXED, __HIP_MEMORY_SCOPE_AGENT); }
__device__ __forceinline__ unsigned xb_add(unsigned* p, unsigned v) { return __hip_atomic_fetch_add(p, v, __ATOMIC_RELAXED, __HIP_MEMORY_SCOPE_AGENT); }
__device__ __forceinline__ unsigned xb_xcc_id() { return (unsigned)__builtin_amdgcn_s_getreg((3 << 11) | 20) & 0xFu; }
#define XB_SPIN(cond, bar) do { unsigned _sp = 0; while (cond) { __builtin_amdgcn_s_sleep(1); \
    if ((++_sp & 255u) == 0u) { if (xb_ld(&(bar)[XB_TMO])) break; if (_sp > XB_SPIN_CAP) { atomicAdd(&(bar)[XB_TMO], 1u); break; } } } } while (0)

struct XcdBarrier {
    unsigned* bar; unsigned x;
    volatile LAS unsigned* st;
};

__device__ __forceinline__ XcdBarrier xcd_barrier_post(unsigned* bar, volatile LAS unsigned* st) {
    XcdBarrier b; b.bar = bar; b.x = xb_xcc_id(); b.st = st;
    if (threadIdx.x == 0) (void)xb_add(&bar[XB_XCNT(b.x)], 1u);
    return b;
}
__device__ __forceinline__ void xcd_barrier_complete(unsigned* bar, unsigned x, unsigned& nloc, unsigned& nx) {
    const unsigned G = gridDim.x * gridDim.y * gridDim.z;
    unsigned sum, cnt, mine, sp = 0u;
    for (;;) {
        sum = 0u; cnt = 0u; mine = 0u;
#pragma unroll
        for (unsigned j = 0; j < 16; ++j) { const unsigned c = xb_ld(&bar[XB_XCNT(j)]); sum += c; cnt += (c > 0u) ? 1u : 0u; mine = (j == x) ? c : mine; }
        if (sum == G) break;
        __builtin_amdgcn_s_sleep(1);
        if ((++sp & 255u) == 0u) { if (xb_ld(&bar[XB_TMO])) break; if (sp > XB_SPIN_CAP) { atomicAdd(&bar[XB_TMO], 1u); break; } }
    }
    nloc = mine > 0u ? mine : 1u; nx = cnt > 0u ? cnt : 1u;
}

__device__ __forceinline__ void xcd_barrier(const XcdBarrier& b) {
    asm volatile("s_waitcnt vmcnt(0)" ::: "memory");
    __syncthreads();
    if (threadIdx.x == 0) {
        unsigned* bar = b.bar;
        __builtin_amdgcn_s_waitcnt(0);
        unsigned nloc = b.st[0], nx = b.st[1];
        if (nloc == 0u) { xcd_barrier_complete(bar, b.x, nloc, nx); b.st[0] = nloc; b.st[1] = nx; }
        const unsigned old = xb_add(&bar[XB_XSUB(b.x)], 1u);
        const unsigned gen = old / nloc;
        if (old + 1u == (gen + 1u) * nloc) {
            __builtin_amdgcn_fence(__ATOMIC_RELEASE, "agent");
            asm volatile("s_waitcnt vmcnt(0)" ::: "memory");
            const unsigned og = xb_add(&bar[XB_TOP], 1u);
            const unsigned tg = og / nx;
            if (og + 1u == (tg + 1u) * nx) xb_add(&bar[XB_TOPGEN], 1u);
            else XB_SPIN(xb_ld(&bar[XB_TOPGEN]) == tg, bar);
            __builtin_amdgcn_fence(__ATOMIC_ACQUIRE, "agent");
            xb_add(&bar[XB_XGEN(b.x)], 1u);
            asm volatile("s_waitcnt vmcnt(0)" ::: "memory");
        } else {
            XB_SPIN(xb_ld(&bar[XB_XGEN(b.x)]) == gen, bar);
            __builtin_amdgcn_fence(__ATOMIC_ACQUIRE, "agent");
            asm volatile("s_waitcnt vmcnt(0)" ::: "memory");
        }
    }
    __syncthreads();
}

struct Frame {
    LAS unsigned char* lds;
    int tid, lane, wave, G, vcu;
};
__device__ __forceinline__ float wave_sum(float v) {
#pragma unroll
    for (int o = 1; o < 64; o <<= 1) v += __shfl_xor(v, o);
    return v;
}
__device__ __forceinline__ unsigned f2bf(float f) { unsigned u = __builtin_bit_cast(unsigned, f); return (u + 0x7fffu + ((u >> 16) & 1u)) >> 16; }
__device__ __forceinline__ unsigned pk2(float lo, float hi) { return cvtpk(lo, hi); }

__device__ __forceinline__ void xpose_load(const float* W, int ldw, int src_col0, int k0, int lane, f32x4 (&v)[8]) {
    const int kc = lane & 7, ng = lane >> 3;
    if (src_col0 < 0) {
#pragma unroll
        for (int e = 0; e < 8; ++e) v[e] = (f32x4){0.f, 0.f, 0.f, 0.f};
        return; }
    const float* p = W + (size_t)(k0 + 8 * kc) * ldw + src_col0 + 4 * ng;
#pragma unroll
    for (int e = 0; e < 8; ++e) v[e] = __builtin_nontemporal_load((const GAS f32x4*)(p + (size_t)e * ldw));
}
__device__ __forceinline__ void xpose_store(const f32x4 (&v)[8], const float* gain, bf16* WT, int K, int dst_row0, int k0, int lane) {
    const int kc = lane & 7, ng = lane >> 3;
    f32x4 g0 = {1.f, 1.f, 1.f, 1.f}, g1 = g0;
    if (gain) { g0 = *(const GAS f32x4*)(gain + k0 + 8 * kc); g1 = *(const GAS f32x4*)(gain + k0 + 8 * kc + 4); }
    bf16* o = WT + (size_t)(dst_row0 + 4 * ng) * K + k0 + 8 * kc;
#pragma unroll
    for (int i = 0; i < 4; ++i) { v4u w; w.x = pk2(v[0][i] * g0[0], v[1][i] * g0[1]); w.y = pk2(v[2][i] * g0[2], v[3][i] * g0[3]); w.z = pk2(v[4][i] * g1[0], v[5][i] * g1[1]); w.w = pk2(v[6][i] * g1[2], v[7][i] * g1[3]);
        *(GAS v4u*)(o + (size_t)i * K) = w; }
}
__device__ __forceinline__ void xpose_store8(const f32x4 (&v)[8], const float* gain, float scale, unsigned char* WT, int K, int dst_row0, int k0, int lane) {
    const int kc = lane & 7, ng = lane >> 3;
    f32x4 g0 = {scale, scale, scale, scale}, g1 = g0;
    if (gain) { g0 = *(const GAS f32x4*)(gain + k0 + 8 * kc) * scale; g1 = *(const GAS f32x4*)(gain + k0 + 8 * kc + 4) * scale; }
    unsigned char* o = WT + (size_t)(dst_row0 + 4 * ng) * K + k0 + 8 * kc;
#pragma unroll
    for (int i = 0; i < 4; ++i) { *(GAS v2u*)(o + (size_t)i * K) = pg8::pack8_fp8((f32x4){v[0][i] * g0[0], v[1][i] * g0[1], v[2][i] * g0[2], v[3][i] * g0[3]}, (f32x4){v[4][i] * g1[0], v[5][i] * g1[1], v[6][i] * g1[2], v[7][i] * g1[3]}); }
}
__device__ __forceinline__ void xpose_item2(const float* Wa, int srca, const float* Wb, int srcb, int ldw, const float* gain, bf16* WT, int K, int dst_row0, int k0, int lane) {
    f32x4 va[8], vb[8];
    xpose_load(Wa, ldw, srca, k0, lane, va); xpose_load(Wb, ldw, srcb, k0, lane, vb);
    xpose_store(va, gain, WT, K, dst_row0, k0, lane); xpose_store(vb, gain, WT, K, dst_row0 + 32, k0, lane);
}
__device__ __forceinline__ void sincos_acc(float ang, float& sn, float& cs) {
    const double a = (double)ang; const double kq = __builtin_rint(a * 0.6366197723675814); const double r = __builtin_fma(-kq, 1.5707963267948966, a) - kq * 6.123233995736766e-17;
    const double r2 = r * r;
    double sp = 1.6059043836821613e-10; sp = sp * r2 - 2.505210838544172e-08; sp = sp * r2 + 2.7557319223985893e-06; sp = sp * r2 - 0.0001984126984126984; sp = sp * r2 + 0.008333333333333333; sp = sp * r2 - 0.16666666666666666; sp = sp * r2 * r + r;
    double cp = 2.08767569878681e-09; cp = cp * r2 - 2.755731922398589e-07; cp = cp * r2 + 2.48015873015873e-05; cp = cp * r2 - 0.001388888888888889; cp = cp * r2 + 0.041666666666666664; cp = cp * r2 - 0.5; cp = cp * r2 + 1.0;
    const int q = (int)kq & 3;
    const double s = (q == 0) ? sp : (q == 1) ? cp : (q == 2) ? -sp : -cp;
    const double c = (q == 0) ? cp : (q == 1) ? -sp : (q == 2) ? -cp : sp;
    sn = (float)s; cs = (float)c;
}

struct In { const float *x, *p, *w_in, *g_attn, *g_q, *g_kv, *w_uq, *w_ukv, *w_o, *g_ffn, *w_gate, *w_up, *conv_w, *conv_b, *w_down, *g_ple, *w_pg, *w_pp, *g_final; };
struct Args { In in; float* out; unsigned char* ws; int ph_lo, ph_hi; };

__device__ __forceinline__ double ipow_d(double c, int j, int nbits) { double inv = 1.0, p = c; for (int b = 0; b < nbits; ++b) { if ((j >> b) & 1) inv *= p; p *= p; } return inv; }

__device__ __forceinline__ void p0_prologue(Frame& F, const In& I, unsigned char* ws) {
    const int gw = F.vcu * NWAVES + F.wave, NGW = F.G * NWAVES, lane = F.lane;
    bf16* Win_t = (bf16*)(ws + WS_WIN); unsigned char* Win8_t = ws + WS_WIN8; unsigned char* Wuq8_t = ws + WS_WUQ; unsigned char* Wukv8_t = ws + WS_WUKV;
    constexpr int I_IN = 128 * 64, I_IN8 = 28 * 64, I_UQ = 48 * 16, I_UKV = 64 * 8, I_PP = 64 * 4, NITEMS = I_IN + I_IN8 + I_UQ + I_UKV + I_PP;
    for (int it = gw; it < NITEMS; it += NGW) {
        int r = it;
        if (r < I_IN) { const int n0 = 64 * (r >> 6), k0 = 64 * (r & 63); xpose_item2(I.w_in, n0, I.w_in, n0 + 32, 9792, nullptr, Win_t, 4096, n0, k0, lane); continue; } r -= I_IN;
        if (r < I_IN8) { const int n0 = 64 * (r >> 6), k0 = 64 * (r & 63); int sa = 8192 + n0, sb = 8192 + n0 + 32;
            if (n0 >= 1536) { const int c = n0 - 1536; sa = (c == 0) ? 9728 : (c == 128 ? 9760 : -1); sb = -1; }
            f32x4 va[8], vb[8]; xpose_load(I.w_in, 9792, sa, k0, lane, va); xpose_load(I.w_in, 9792, sb, k0, lane, vb);
            xpose_store8(va, nullptr, pg8::W8_SCALE, Win8_t, 4096, n0, k0, lane); xpose_store8(vb, nullptr, pg8::W8_SCALE, Win8_t, 4096, n0 + 32, k0, lane); continue; } r -= I_IN8;
        if (r < I_UQ) { const int n0 = 64 * (r >> 4), k0 = 64 * (r & 15), pn = n0 >> 8; int sa, sb;
            { const int c = n0 & 255; if (pn < 8) sa = 192 * (2 * pn + (c >> 7)) + (c & 127); else sa = 192 * (4 * (pn - 8) + ((c & 127) >> 5)) + 128 + 32 * (c >> 7); }
            { const int c = (n0 + 32) & 255; if (pn < 8) sb = 192 * (2 * pn + (c >> 7)) + (c & 127); else sb = 192 * (4 * (pn - 8) + ((c & 127) >> 5)) + 128 + 32 * (c >> 7); }
            { f32x4 va[8], vb[8]; xpose_load(I.w_uq, 3072, sa, k0, lane, va); xpose_load(I.w_uq, 3072, sb, k0, lane, vb); xpose_store8(va, I.g_q, pg8::WQ8_SCALE, Wuq8_t, 1024, n0, k0, lane); xpose_store8(vb, I.g_q, pg8::WQ8_SCALE, Wuq8_t, 1024, n0 + 32, k0, lane); } continue; } r -= I_UQ;
        if (r >= I_UKV) { r -= I_UKV; const int n0 = 64 * (r >> 2), k0 = 64 * (r & 3); xpose_item2(I.w_pp, n0, I.w_pp, n0 + 32, 4096, nullptr, (bf16*)(ws + WS_WPP), 256, n0, k0, lane); continue; }
        { const int n0 = 64 * (r >> 3), k0 = 64 * (r & 7); f32x4 va[8], vb[8]; xpose_load(I.w_ukv, 4096, n0, k0, lane, va); xpose_load(I.w_ukv, 4096, n0 + 32, k0, lane, vb); xpose_store8(va, I.g_kv, pg8::WQ8_SCALE, Wukv8_t, 512, n0, k0, lane); xpose_store8(vb, I.g_kv, pg8::WQ8_SCALE, Wukv8_t, 512, n0 + 32, k0, lane); }
    }
    bf16* XB = (bf16*)(ws + WS_XB);
    for (int m = gw; m < M; m += NGW) {
        const GAS f32x4* xr = (const GAS f32x4*)(I.x + (size_t)m * DM) + lane; const GAS f32x4* gr = (const GAS f32x4*)I.g_attn + lane;
        f32x4 v[16]; float s = 0.f;
#pragma unroll
        for (int j = 0; j < 16; ++j) { v[j] = __builtin_nontemporal_load(xr + 64 * j); s += (v[j].x * v[j].x + v[j].y * v[j].y) + (v[j].z * v[j].z + v[j].w * v[j].w); }
        const float rstd = 1.0f / sqrtf(wave_sum(s) * (1.0f / DM) + 1e-6f);
        GAS v2u* o8 = (GAS v2u*)(XB + (size_t)m * DM) + lane; GAS unsigned* o1 = (GAS unsigned*)(ws + WS_XB8 + (size_t)m * DM) + lane;
#pragma unroll
        for (int j = 0; j < 16; ++j) { const f32x4 g = gr[64 * j]; const float y0 = v[j].x * rstd * g.x, y1 = v[j].y * rstd * g.y, y2 = v[j].z * rstd * g.z, y3 = v[j].w * rstd * g.w;
            v2u o; o.x = pk2(y0, y1); o.y = pk2(y2, y3); o8[64 * j] = o;
            int w8 = __builtin_amdgcn_cvt_pk_fp8_f32(y0, y1, 0, false); w8 = __builtin_amdgcn_cvt_pk_fp8_f32(y2, y3, w8, true); o1[64 * j] = (unsigned)w8; }
    }
    { bf16* PB = (bf16*)(ws + WS_PB);
      for (int i = gw * 64 + lane; i < M * 256 / 8; i += NGW * 64) { const f32x4 a = *(const GAS f32x4*)(I.p + (size_t)i * 8), b = *(const GAS f32x4*)(I.p + (size_t)i * 8 + 4);
          v4u o; o.x = pk2(a.x, a.y); o.y = pk2(a.z, a.w); o.z = pk2(b.x, b.y); o.w = pk2(b.z, b.w); *(GAS v4u*)(PB + (size_t)i * 8) = o; } }
    { float* cosR = (float*)(ws + WS_COSR); float* sinR = (float*)(ws + WS_SINR); float* cosM = (float*)(ws + WS_COSM); float* sinM = (float*)(ws + WS_SINM);
      for (int i = gw * 64 + lane; i < SEQ * 160; i += NGW * 64) {
          if (i < SEQ * 128) { const int pos = i >> 7, j = i & 127; const float inv = (float)ipow_d(0.930572040929699, j, 7); float sn, cs; sincos_acc((float)pos * inv, sn, cs); cosR[i] = cs; sinR[i] = sn; }
          else { const int k = i - SEQ * 128, pos = k >> 5, j = k & 31; const float inv = (float)ipow_d(0.7498942093324559, j, 5); float sn, cs; sincos_acc((float)pos * inv, sn, cs); cosM[k] = cs; sinM[k] = sn; } } }
}

constexpr int CV_O = 128 * 64, CV_GU = 688 * 64, CV_N = CV_O + CV_GU;
constexpr int CV_PRE = CV_O;
__device__ __forceinline__ void cv_load(const In& I, int it, int lane, f32x4 (&v)[8]) {
    if (it < CV_O) { xpose_load(I.w_o, 4096, 32 * (it >> 6), 64 * (it & 63), lane, v); return; }
    const int r = it - CV_O, n0 = 32 * (r >> 6), k0 = 64 * (r & 63), pn = n0 >> 8, cc = n0 & 255, src = 128 * pn + (cc & 127);
    if (cc < 128) xpose_load(I.w_gate, NFF, src, k0, lane, v); else xpose_load(I.w_up, NFF, src, k0, lane, v);
}
__device__ __forceinline__ void cv_store(const In& I, unsigned char* ws, int it, int lane, const f32x4 (&v)[8]) {
    if (it < CV_O) { const int n0 = 32 * (it >> 6), k0 = 64 * (it & 63);
        if (k0 < 2048) xpose_store(v, nullptr, (bf16*)(ws + WS_WO), CCP, n0, k0, lane); else xpose_store8(v, nullptr, pg8::W8_SCALE, ws + WS_WO + 4096, 2 * CCP, n0, k0 - 2048, lane); return; }
    const int r = it - CV_O; xpose_store(v, I.g_ffn, (bf16*)(ws + WS_WGU), 4096, 32 * (r >> 6), 64 * (r & 63), lane);
}
__device__ __forceinline__ void cvg_load(const In& I, int it, int lane, f32x4 (&v)[8]) {
    const int r = it - CV_O, n0 = 32 * (r >> 6), k0 = 64 * (r & 63), pn = n0 >> 8, cc = n0 & 255, src = 128 * pn + (cc & 127);
    if (cc < 128) xpose_load(I.w_gate, NFF, src, k0, lane, v); else xpose_load(I.w_up, NFF, src, k0, lane, v);
}
__device__ __forceinline__ void cvg_store(const In& I, unsigned char* ws, int it, int lane, const f32x4 (&v)[8]) {
    const int r = it - CV_O; xpose_store(v, I.g_ffn, (bf16*)(ws + WS_WGU), 4096, 32 * (r >> 6), 64 * (r & 63), lane);
}
__device__ __forceinline__ void pre_convert(Frame& F, const In& I, unsigned char* ws, int rank, int nranks, int n_items) {
    const int gw = rank * NWAVES + F.wave, NGW = nranks * NWAVES, lane = F.lane;
    for (int it = gw; it < n_items; it += 2 * NGW) { f32x4 va[8], vb[8]; const int it2 = it + NGW;
        cv_load(I, it, lane, va); if (it2 < n_items) cv_load(I, it2, lane, vb);
        cv_store(I, ws, it, lane, va); if (it2 < n_items) cv_store(I, ws, it2, lane, vb); }
}
namespace ret {
constexpr int LQ = 0, LK = 32768, LV = 65536, LV2 = 69632, LS = 73728, LRED = 106496;
__device__ __forceinline__ int off_k(int row, int ch) { return 4096 * (row >> 3) + 512 * (ch >> 2) + 64 * (row & 7) + 16 * ((ch & 3) ^ ((row >> 2) & 3)); }
__device__ __forceinline__ int off_v(int row, int ch) { return 512 * (row >> 3) + 64 * (row & 7) + 16 * (ch ^ ((row >> 2) & 3)); }
}
__device__ __forceinline__ void retention_phase(Frame& F, const In& I, unsigned char* ws, int cv_base) {
    using namespace ret;
    LAS unsigned char* lds = F.lds;
    const int tid = F.tid, lane = F.lane, wid = F.wave, r32 = lane & 31, hi = lane >> 5;
    const bf16* PJ = (const bf16*)(ws + WS_PROJ); bf16* CC = (bf16*)(ws + WS_XB); float* ST = (float*)(ws + WS_STATS);
    const int rowpart = 4096 * (r32 >> 3) + 64 * (r32 & 7), xr = (r32 >> 2) & 3;
    const int baseE = rowpart + 16 * (hi ^ xr), baseO = rowpart + 16 * ((2 + hi) ^ xr);
    const int tq = (lane & 15) >> 2, tp = lane & 3, tblk = (lane >> 4) & 1;
    const int trk0 = 4096 * hi + 64 * tq + 16 * ((2 * tblk + (tp >> 1)) ^ (2 * hi)) + 8 * (tp & 1);
    const int trk1 = 4096 * hi + 64 * (4 + tq) + 16 * ((2 * tblk + (tp >> 1)) ^ (2 * hi + 1)) + 8 * (tp & 1);
    const int trv0 = 512 * hi + 64 * tq + 16 * ((2 * tblk + (tp >> 1)) ^ (2 * hi)) + 8 * (tp & 1);
    const int trv1 = 512 * hi + 64 * (4 + tq) + 16 * ((2 * tblk + (tp >> 1)) ^ (2 * hi + 1)) + 8 * (tp & 1);
    for (int unit = blockIdx.x; unit < 256; unit += F.G) {
        const int bh = (unit & 7) + 8 * ((unit >> 3) & 3), sl = unit >> 5, b = bh >> 3, h = bh & 7;
        float lg; { const double e = 1.0 / (double)(32 << h); double t = e, acc = 0.0; for (int k = 1; k <= 10; ++k) { acc += t / (double)k; t *= e; } lg = (float)(-acc * 1.4426950408889634); }
        const float a64 = exp2f(lg * 64.0f);
        const size_t rowbase = (size_t)b * SEQ;
        const bool intra = (wid < 2), inter = (wid == 2 || wid == 3 || wid == 6 || wid == 7);
        const int qb = wid & 1, dkh = (wid >> 2) & 1;
        LAS float* gt = (LAS float*)(lds + 132096);
        if (tid <= 64) gt[tid] = exp2f(lg * (float)tid);
        const int nq = 32 * qb + r32;
        f32x16 S = {};
        const int vrow = (tid >> 2) & 63, vch = tid & 3; const float kd = exp2f(lg * (float)(63 - vrow));
        v4u sq[4], sk[4], sv;
        const unsigned qoff = (unsigned)(((tid >> 5) * LDP + 8 * (tid & 31)) * 2), voffg = (unsigned)((vrow * LDP + 4096 + 32 * sl + 8 * vch) * 2);
#define RET_LOAD(c) do { const char* base_ = (const char*)(PJ + (rowbase + (size_t)(c) * 64) * LDP + h * 256); \
        _Pragma("unroll") for (int i_ = 0; i_ < 4; ++i_) { const char* rb_ = base_ + (size_t)i_ * 16 * LDP * 2; sq[i_] = *(const GAS v4u*)(rb_ + qoff); sk[i_] = *(const GAS v4u*)(rb_ + 4096 + qoff); } \
        sv = *(const GAS v4u*)(base_ + voffg); } while (0)
#define RET_WRITE() do { _Pragma("unroll") for (int i_ = 0; i_ < 4; ++i_) { const int id_ = tid + 512 * i_; const int o_ = off_k(id_ >> 5, id_ & 31); *(LAS v4u*)(lds + LQ + o_) = sq[i_]; *(LAS v4u*)(lds + LK + o_) = sk[i_]; } \
        if (tid < 256) { const int o_ = off_v(vrow, vch); *(LAS v4u*)(lds + LV + o_) = sv; v4u w_; \
            w_.x = cvtpk(bflo(sv.x) * kd, bfhi(sv.x) * kd); w_.y = cvtpk(bflo(sv.y) * kd, bfhi(sv.y) * kd); w_.z = cvtpk(bflo(sv.z) * kd, bfhi(sv.z) * kd); w_.w = cvtpk(bflo(sv.w) * kd, bfhi(sv.w) * kd); \
            *(LAS v4u*)(lds + LV2 + o_) = w_; } } while (0)
        f32x4 cva[8]; int cv_prev = -1; const int cv_slot = (unit - (int)blockIdx.x) / F.G * 384 + (wid - 2);
        RET_LOAD(0);
        for (int i = tid; i < 1024; i += 512) *(LAS v4u*)(lds + LS + 16 * i) = (v4u){0u, 0u, 0u, 0u};
        VM_WAIT(); RET_WRITE(); LDS_WAIT(); __builtin_amdgcn_s_barrier(); asm volatile("" ::: "memory");
        for (int c = 0; c < 64; ++c) {
            const int cur = c & 1;

            if (c + 1 < 64) RET_LOAD(c + 1);
            if (wid >= 2) {
                if (cv_prev >= 0) cvg_store(I, ws, cv_prev, lane, cva);
                const int it = cv_base + (cv_slot + 6 * c) * F.G + (int)blockIdx.x;
                if (it < CV_N) { cvg_load(I, it, lane, cva); cv_prev = it; } else cv_prev = -1;
            }
            if (intra) {
                f32x16 p0 = {}, p1 = {};
#pragma unroll
                for (int d0 = 0; d0 < 16; ++d0) { const int o_ = ((d0 & 1) ? baseO : baseE) + 512 * (d0 >> 1);
                    const bf16x8 a0 = *(const LAS bf16x8*)(lds + LK + o_), a1 = *(const LAS bf16x8*)(lds + LK + 16384 + o_), bq = *(const LAS bf16x8*)(lds + LQ + 16384 * qb + o_);
                    p0 = __builtin_amdgcn_mfma_f32_32x32x16_bf16(a0, bq, p0, 0, 0, 0); p1 = __builtin_amdgcn_mfma_f32_32x32x16_bf16(a1, bq, p1, 0, 0, 0); if ((d0 & 3) == 3) SBAR(); }
#pragma unroll
                for (int r = 0; r < 16; ++r) { const int m0 = crow(r, hi); p0[r] *= gt[nq > m0 ? nq - m0 : m0 - nq]; p1[r] *= gt[nq > m0 + 32 ? nq - m0 - 32 : m0 + 32 - nq]; }
                bf16x8 pa0, pa1, pa2, pa3;
#define PK4(P, B_, OUT) do { unsigned a0_ = cvtpk(P[B_ + 0], P[B_ + 1]), a1_ = cvtpk(P[B_ + 2], P[B_ + 3]); unsigned b0_ = cvtpk(P[B_ + 4], P[B_ + 5]), b1_ = cvtpk(P[B_ + 6], P[B_ + 7]); \
        auto r0_ = __builtin_amdgcn_permlane32_swap(a0_, b0_, false, false); auto r1_ = __builtin_amdgcn_permlane32_swap(a1_, b1_, false, false); \
        v4u w_ = {r0_[0], r1_[0], r0_[1], r1_[1]}; OUT = __builtin_bit_cast(bf16x8, w_); } while (0)
                PK4(p0, 0, pa0); PK4(p0, 8, pa1); PK4(p1, 0, pa2); PK4(p1, 8, pa3);
                f32x16 o = {};
#define VFRAG(img, ks) ({ const s16x4 l_ = tr_read(lds + (img) + trv0 + 1024 * (ks)), h_ = tr_read(lds + (img) + trv1 + 1024 * (ks)); (bf16x8){l_[0], l_[1], l_[2], l_[3], h_[0], h_[1], h_[2], h_[3]}; })
                o = __builtin_amdgcn_mfma_f32_32x32x16_bf16(pa0, VFRAG(LV, 0), o, 0, 0, 0); o = __builtin_amdgcn_mfma_f32_32x32x16_bf16(pa1, VFRAG(LV, 1), o, 0, 0, 0);
                o = __builtin_amdgcn_mfma_f32_32x32x16_bf16(pa2, VFRAG(LV, 2), o, 0, 0, 0); o = __builtin_amdgcn_mfma_f32_32x32x16_bf16(pa3, VFRAG(LV, 3), o, 0, 0, 0);
                LAS float* red = (LAS float*)(lds + LRED) + (qb * 3 + 0) * 1024;
#pragma unroll
                for (int r = 0; r < 16; ++r) red[crow(r, hi) * 32 + r32] = o[r];
            } else if (inter) {
                f32x16 o = {};
#pragma unroll
                for (int s8 = 0; s8 < 8; ++s8) { const int d0 = 8 * dkh + s8; const int o_ = ((d0 & 1) ? baseO : baseE) + 512 * (d0 >> 1);
                    const bf16x8 aq = *(const LAS bf16x8*)(lds + LQ + 16384 * qb + o_), bs = *(const LAS bf16x8*)(lds + LS + 16384 * cur + o_);
                    o = __builtin_amdgcn_mfma_f32_32x32x16_bf16(aq, bs, o, 0, 0, 0); }
                LAS float* red = (LAS float*)(lds + LRED) + (qb * 3 + 1 + dkh) * 1024;
#pragma unroll
                for (int r = 0; r < 16; ++r) red[crow(r, hi) * 32 + r32] = o[r] * gt[32 * qb + crow(r, hi) + 1];
            }
#pragma unroll
            for (int r = 0; r < 16; ++r) S[r] *= a64;
#pragma unroll
            for (int ks = 0; ks < 4; ++ks) { const s16x4 l_ = tr_read(lds + LK + trk0 + 8192 * ks + 512 * wid), h_ = tr_read(lds + LK + trk1 + 8192 * ks + 512 * wid);
                const bf16x8 ak = (bf16x8){l_[0], l_[1], l_[2], l_[3], h_[0], h_[1], h_[2], h_[3]};
                S = __builtin_amdgcn_mfma_f32_32x32x16_bf16(ak, VFRAG(LV2, ks), S, 0, 0, 0); }
#pragma unroll
            for (int g = 0; g < 4; ++g) { v2u w_; w_.x = cvtpk(S[4 * g], S[4 * g + 1]); w_.y = cvtpk(S[4 * g + 2], S[4 * g + 3]);
                *(LAS v2u*)(lds + LS + 16384 * (cur ^ 1) + off_k(r32, 4 * wid + g) + 8 * hi) = w_; }
            LDS_WAIT(); __builtin_amdgcn_s_barrier(); asm volatile("" ::: "memory");
            { const int n = tid >> 3, cg = tid & 7, qb2 = n >> 5, row = n & 31;
              const LAS float* rp = (const LAS float*)(lds + LRED) + (qb2 * 3) * 1024 + row * 32 + 4 * cg;
              const f32x4 v = *(const LAS f32x4*)rp + *(const LAS f32x4*)(rp + 1024) + *(const LAS f32x4*)(rp + 2048);
              float s1 = (v[0] + v[1]) + (v[2] + v[3]), s2 = (v[0] * v[0] + v[1] * v[1]) + (v[2] * v[2] + v[3] * v[3]);
              s1 += __shfl_xor(s1, 1); s2 += __shfl_xor(s2, 1); s1 += __shfl_xor(s1, 2); s2 += __shfl_xor(s2, 2); s1 += __shfl_xor(s1, 4); s2 += __shfl_xor(s2, 4);
              const size_t t = rowbase + (size_t)c * 64 + n;
              v2u w_; w_.x = cvtpk(v[0], v[1]); w_.y = cvtpk(v[2], v[3]);
              *(GAS v2u*)(CC + t * CCP + h * 256 + 32 * sl + 4 * cg) = w_;
              if (cg == 0) { float* sp = ST + ((t * 8 + h) * 8 + sl) * 2; sp[0] = s1; sp[1] = s2; } }
            if (c + 1 < 64) { RET_WRITE(); }
            LDS_WAIT(); __builtin_amdgcn_s_barrier(); asm volatile("" ::: "memory");
        }
        if (wid >= 2 && cv_prev >= 0) cvg_store(I, ws, cv_prev, lane, cva);
#undef RET_LOAD
#undef RET_WRITE
#undef PK4
    }
}

__device__ __forceinline__ void ro_finalize(Frame& F, unsigned char* ws) {
    const int gw = F.vcu * NWAVES + F.wave, NGW = F.G * NWAVES, lane = F.lane;
    bf16* CC = (bf16*)(ws + WS_XB); const bf16* PJ = (const bf16*)(ws + WS_PROJ); const float* ST = (const float*)(ws + WS_STATS);
    for (int it0 = gw; it0 < M * 8; it0 += 4 * NGW) {
        f32x4 st[4][4]; v2u rv[4], gv[4];
#pragma unroll
        for (int k = 0; k < 4; ++k) { const int it = it0 + k * NGW; if (it < M * 8) { const size_t t = (size_t)(it >> 3); const int h = it & 7; const f32x4* sp = (const f32x4*)(ST + (size_t)it * 16);
            st[k][0] = sp[0]; st[k][1] = sp[1]; st[k][2] = sp[2]; st[k][3] = sp[3]; rv[k] = *(const GAS v2u*)(CC + t * CCP + h * 256 + 4 * lane); gv[k] = *(const GAS v2u*)(PJ + t * LDP + 6144 + h * 256 + 4 * lane); } }
#pragma unroll
        for (int k = 0; k < 4; ++k) { const int it = it0 + k * NGW; if (it < M * 8) { const size_t t = (size_t)(it >> 3); const int h = it & 7;
            const f32x4 a = st[k][0], b = st[k][1], c = st[k][2], d = st[k][3];
            const float s1 = ((a[0] + a[2]) + (b[0] + b[2])) + ((c[0] + c[2]) + (d[0] + d[2])), s2 = ((a[1] + a[3]) + (b[1] + b[3])) + ((c[1] + c[3]) + (d[1] + d[3]));
            const float mu = s1 * (1.0f / 256.0f), var = fmaxf(s2 * (1.0f / 256.0f) - mu * mu, 0.f), rstd = 1.0f / sqrtf(var + 1e-6f);
            float r[4] = {bflo(rv[k].x), bfhi(rv[k].x), bflo(rv[k].y), bfhi(rv[k].y)}, g[4] = {bflo(gv[k].x), bfhi(gv[k].x), bflo(gv[k].y), bfhi(gv[k].y)}, o[4];
#pragma unroll
            for (int i = 0; i < 4; ++i) { const float sg = g[i] / (1.0f + __expf(-g[i])); o[i] = (r[i] - mu) * rstd * sg; }
            v2u w; w.x = pk2(o[0], o[1]); w.y = pk2(o[2], o[3]); *(GAS v2u*)(CC + t * CCP + h * 256 + 4 * lane) = w; } }
    }
}

namespace att {
constexpr int KT = 12288, VT = 8192, LK0 = 0, LV0 = 2 * KT, LWS = 132096;
constexpr float SCALE = 0.07216878364870322f, C2 = 0.10411754627697264f, THR = 5.f;
__device__ __forceinline__ int off_k8(int row, int ch) { return 192 * row + 64 * (ch >> 2) + 16 * ((ch & 3) ^ ((row >> 2) & 3)); }
__device__ __forceinline__ int off_v8(int row, int ch) { return 64 * row + 16 * (ch ^ ((row >> 2) & 3)); }
typedef int v8i32 __attribute__((ext_vector_type(8)));
typedef int v4i32 __attribute__((ext_vector_type(4)));
}
__device__ __forceinline__ void attn_unit(Frame& F, unsigned char* ws, int b, int h, int qblk) {
    using namespace att;
    LAS unsigned char* lds = F.lds;
    const int tid = F.tid, lane = F.lane, wid = F.wave, r32 = lane & 31, hi = lane >> 5;
    const size_t rowbase = (size_t)b * SEQ; const int q0 = 256 * qblk, NT = 4 * qblk + 4, my_last = 4 * qblk + (wid >> 1);
    LAS float* wsf = (LAS float*)(lds + LWS) + wid * 64;
    const rsrc_t rs = make_rsrc(ws);
    v4u sk0, sk1, sv;
    const unsigned knoff = (unsigned)((tid >> 3) * 2048 + 16 * (tid & 7)), kroff = (unsigned)(((tid >> 2) & 63) * 64 + 16 * (tid & 3)), vtoff = (unsigned)((tid >> 2) * 4096 + 16 * (tid & 3));
    const unsigned vbase_g = (unsigned)WS_VB + (unsigned)((b * 16 + h) * 128) * 4096u;
#define AT_LOAD(t) do { const unsigned kr_ = (unsigned)(rowbase + (size_t)(t) * 64); \
        sk0 = bufld16(rs, knoff, (unsigned)WS_KB + kr_ * 2048u + 128u * h); if (tid < 256) sk1 = bufld16(rs, kroff, (unsigned)WS_KR + kr_ * 64u); \
        sv = bufld16(rs, vtoff, vbase_g + 64u * (unsigned)(t)); } while (0)
#define AT_WRITE(buf) do { *(LAS v4u*)(lds + LK0 + (buf) * KT + off_k8(tid >> 3, tid & 7)) = sk0; if (tid < 256) *(LAS v4u*)(lds + LK0 + (buf) * KT + off_k8(tid >> 2, 8 + (tid & 3))) = sk1; \
        *(LAS v4u*)(lds + LV0 + (buf) * VT + off_v8(tid >> 2, tid & 3)) = sv; } while (0)
    v8i32 qf[3];
    { const unsigned qv = (unsigned)(r32 * 3072 + 32 * hi), qs = (unsigned)WS_Q + (unsigned)((rowbase + q0 + 32 * wid) * 3072 + 192 * h);
#pragma unroll
      for (int s = 0; s < 3; ++s) { qf[s].lo = __builtin_bit_cast(v4i32, bufld16(rs, qv, qs + 64 * s)); qf[s].hi = __builtin_bit_cast(v4i32, bufld16(rs, qv, qs + 64 * s + 16)); } }
    const int xk = (r32 >> 2) & 3;
    const int kb0 = 192 * r32 + 16 * ((2 * hi) ^ xk), kb1 = 192 * r32 + 16 * ((2 * hi + 1) ^ xk);
    const int vb0 = 64 * r32 + 16 * ((2 * hi) ^ xk), vb1 = 64 * r32 + 16 * ((2 * hi + 1) ^ xk);
    const int unit_scale = 0x7f7f7f7f;
    float m_reg = -1e30f, l_reg = 0.f; f32x16 o[4] = {};
    AT_LOAD(0); VM_WAIT(); AT_WRITE(0);
    if (NT > 1) AT_LOAD(1);
    LDS_WAIT(); __builtin_amdgcn_s_barrier(); asm volatile("" ::: "memory");
    for (int t = 0; t < NT; ++t) {
        const int buf = t & 1;
        const bool active = (t <= my_last);
        if (!active && t + 1 < NT) { AT_WRITE(buf ^ 1); if (t + 2 < NT) AT_LOAD(t + 2); }
        if (active) {
            f32x16 p0 = {}, p1 = {};
            const LAS unsigned char* kbase = lds + LK0 + buf * KT;
#pragma unroll
            for (int s = 0; s < 3; ++s) { v8i32 k0, k1;
                k0.lo = *(const LAS v4i32*)(kbase + kb0 + 64 * s); k0.hi = *(const LAS v4i32*)(kbase + kb1 + 64 * s); k1.lo = *(const LAS v4i32*)(kbase + 6144 + kb0 + 64 * s); k1.hi = *(const LAS v4i32*)(kbase + 6144 + kb1 + 64 * s);
                p0 = __builtin_amdgcn_mfma_scale_f32_32x32x64_f8f6f4(k0, qf[s], p0, 0, 0, 0, unit_scale, 0, unit_scale); p1 = __builtin_amdgcn_mfma_scale_f32_32x32x64_f8f6f4(k1, qf[s], p1, 0, 0, 0, unit_scale, 0, unit_scale); }
            if (t + 1 < NT) { AT_WRITE(buf ^ 1); if (t + 2 < NT) AT_LOAD(t + 2); }
            float pmax = p0[0];
#pragma unroll
            for (int r = 1; r < 16; ++r) pmax = fmaxf(pmax, p0[r]);
#pragma unroll
            for (int r = 0; r < 16; ++r) pmax = fmaxf(pmax, p1[r]);
            { auto rr = __builtin_amdgcn_permlane32_swap(__float_as_uint(pmax), __float_as_uint(pmax), false, false); pmax = fmaxf(__uint_as_float(rr[0]), __uint_as_float(rr[1])); }
            float mn, alpha;
            if (__all((pmax - m_reg) * SCALE <= THR)) { mn = m_reg; alpha = 1.f; }
            else { mn = fmaxf(m_reg, pmax); alpha = __builtin_amdgcn_exp2f((m_reg - mn) * C2); m_reg = mn; }
            const float mnL = -mn * C2;
#pragma unroll
            for (int r = 0; r < 16; ++r) { p0[r] = __builtin_amdgcn_exp2f(fmaf(p0[r], C2, mnL)); p1[r] = __builtin_amdgcn_exp2f(fmaf(p1[r], C2, mnL)); }
            float ps = 0.f;
#pragma unroll
            for (int r = 0; r < 16; ++r) ps += p0[r] + p1[r];
            { auto rr = __builtin_amdgcn_permlane32_swap(__float_as_uint(ps), __float_as_uint(ps), false, false); ps = __uint_as_float(rr[0]) + __uint_as_float(rr[1]); }
            l_reg = l_reg * alpha + ps;
            if (__any(alpha < 1.f)) { if (hi == 0) wsf[r32] = alpha; LDS_WAIT();
#pragma unroll
                for (int r = 0; r < 16; ++r) { const float al = wsf[crow(r, hi)];
#pragma unroll
                    for (int c = 0; c < 4; ++c) o[c][r] *= al; } }
            v8i32 P8;
#pragma unroll
            for (int d = 0; d < 4; ++d) { int w0 = __builtin_amdgcn_cvt_pk_fp8_f32(p0[4 * d], p0[4 * d + 1], 0, false); w0 = __builtin_amdgcn_cvt_pk_fp8_f32(p0[4 * d + 2], p0[4 * d + 3], w0, true); P8[d] = w0;
                int w1 = __builtin_amdgcn_cvt_pk_fp8_f32(p1[4 * d], p1[4 * d + 1], 0, false); w1 = __builtin_amdgcn_cvt_pk_fp8_f32(p1[4 * d + 2], p1[4 * d + 3], w1, true); P8[4 + d] = w1; }
            const LAS unsigned char* vbase = lds + LV0 + buf * VT;
#pragma unroll
            for (int c = 0; c < 4; ++c) { v8i32 vf; vf.lo = *(const LAS v4i32*)(vbase + vb0 + 2048 * c); vf.hi = *(const LAS v4i32*)(vbase + vb1 + 2048 * c);
                o[c] = __builtin_amdgcn_mfma_scale_f32_32x32x64_f8f6f4(P8, vf, o[c], 0, 0, 0, unit_scale, 0, unit_scale); }
        }
        LDS_WAIT(); __builtin_amdgcn_s_barrier(); asm volatile("" ::: "memory");
    }
    if (hi == 0) wsf[r32] = l_reg;
    { LAS float* og = (LAS float*)(lds + wid * 16384);
#pragma unroll
      for (int c = 0; c < 4; ++c)
#pragma unroll
          for (int r = 0; r < 16; ++r) og[crow(r, hi) * 128 + 32 * c + r32] = o[c][r];
      LDS_WAIT();
      const unsigned obase = (unsigned)WS_XB + (unsigned)((rowbase + q0 + 32 * wid) * (2 * CCP) + 4096 + 128 * h);
      const unsigned ooff = (unsigned)((lane >> 4) * (2 * CCP) + 8 * (lane & 15));
#pragma unroll
      for (int j = 0; j < 8; ++j) { const int row = (lane >> 4) + 4 * j; const float rl = MO8_SCALE * __builtin_amdgcn_rcpf(wsf[row]);
          const f32x4 a = *(const LAS f32x4*)(og + row * 128 + 8 * (lane & 15)), bq = *(const LAS f32x4*)(og + row * 128 + 8 * (lane & 15) + 4);
          const v2u w = __builtin_bit_cast(v2u, pg8::pack8_fp8(a * rl, bq * rl));
          __builtin_amdgcn_raw_buffer_store_b64(w, rs, (int)ooff, (int)(obase + (unsigned)(j * 4 * 2 * CCP)), 0); } }
    LDS_WAIT(); __builtin_amdgcn_s_barrier(); asm volatile("" ::: "memory");
#undef AT_LOAD
#undef AT_WRITE
}
__device__ __forceinline__ void attn_phase(Frame& F, unsigned char* ws) {
    const int G = F.G;
    for (int slot = (int)blockIdx.x; slot < 512; slot += G) {
        int it = slot;
        if ((G & 7) == 0) { const int x = slot & 7, idx = slot >> 3; it = ((x * 8 + (idx >> 3)) << 3) | (idx & 7); }
        const int bh = it >> 3, y = it & 7;
        for (int e = 0; e < 2; ++e) attn_unit(F, ws, bh >> 4, bh & 15, e ? y : 15 - y);
    }
}

__device__ __forceinline__ void fixup_phase(Frame& F, const In& I, unsigned char* ws) {
    const int gw = F.vcu * NWAVES + F.wave, NGW = F.G * NWAVES, lane = F.lane;
    const float* GT = (const float*)(ws + WS_GT); const float* GH = (const float*)(ws + WS_GH); const float* UH = (const float*)(ws + WS_UH); bf16* ACT = (bf16*)(ws + WS_ACT);
    constexpr int NV = NFF / 4;
    for (int i = gw * 64 + lane; i < NGRP * 2 * NV; i += NGW * 64) {
        const int fv = i % NV, gj = i / NV, j = gj & 1, g = gj >> 1, f = 4 * fv; const bool first = (g & 63) == 0;
        const f32x4 z = {0.f, 0.f, 0.f, 0.f};
        const f32x4 G0 = *(const f32x4*)(GH + ((size_t)g * 2 + j) * NFF + f), U0 = *(const f32x4*)(UH + ((size_t)g * 2 + j) * NFF + f);
        const f32x4 T1 = first ? z : *(const f32x4*)(GT + ((size_t)(g - 1) * 2 + 1) * NFF + f), T0 = first ? z : *(const f32x4*)(GT + ((size_t)(g - 1) * 2 + 0) * NFF + f);
        const f32x4 G1 = j ? *(const f32x4*)(GH + ((size_t)g * 2) * NFF + f) : T1, G2 = j ? T1 : T0;
        const f32x4 w0 = *(const f32x4*)(I.conv_w + f), w1 = *(const f32x4*)(I.conv_w + NFF + f), w2 = *(const f32x4*)(I.conv_w + 2 * NFF + f), bb = *(const f32x4*)(I.conv_b + f);
        float o[4];
#pragma unroll
        for (int e = 0; e < 4; ++e) { const float a = bb[e] + w0[e] * G2[e] + w1[e] * G1[e] + w2[e] * G0[e]; o[e] = a / (1.0f + __expf(-a)) * U0[e]; }
        v2u w; w.x = pk2(o[0], o[1]); w.y = pk2(o[2], o[3]); *(GAS v2u*)(ACT + ((size_t)g * 64 + j) * NFF + f) = w;
    }
}
__device__ __forceinline__ void late_convert(Frame& F, const In& I, unsigned char* ws, int rank, int nranks) {
    const int gw = rank * NWAVES + F.wave, NGW = nranks * NWAVES, lane = F.lane;
    bf16* Wdn_t = (bf16*)(ws + WS_WDN); unsigned char* Wpg8_t = ws + WS_WPG;
    constexpr int I_DN = 64 * 172, I_PG = 64 * 64;
    for (int it = gw; it < I_DN + I_PG; it += NGW) {
        int r = it;
        if (r < I_DN) { const int n0 = 64 * (r / 172), k0 = 64 * (r % 172); xpose_item2(I.w_down, n0, I.w_down, n0 + 32, 4096, nullptr, Wdn_t, NFF, n0, k0, lane); continue; } r -= I_DN;
        { const int n0 = 64 * (r >> 6), k0 = 64 * (r & 63); f32x4 va[8], vb[8]; xpose_load(I.w_pg, 4096, n0, k0, lane, va); xpose_load(I.w_pg, 4096, n0 + 32, k0, lane, vb);
            xpose_store8(va, I.g_ple, pg8::W8_SCALE, Wpg8_t, 4096, n0, k0, lane); xpose_store8(vb, I.g_ple, pg8::W8_SCALE, Wpg8_t, 4096, n0 + 32, k0, lane); }
    }
}

__device__ __forceinline__ void final_norm(Frame& F, const In& I, float* out, const float* ssq3) {
    const int gw = F.vcu * NWAVES + F.wave, NGW = F.G * NWAVES, lane = F.lane;
    for (int m = gw; m < M; m += NGW) {
        const float rstd = 1.0f / sqrtf(ssq3[m] * (1.0f / DM) + 1e-6f);
        GAS f32x4* xr = (GAS f32x4*)(out + (size_t)m * DM) + lane; const GAS f32x4* gr = (const GAS f32x4*)I.g_final + lane;
#pragma unroll
        for (int j = 0; j < 16; ++j) { const f32x4 v = xr[64 * j], g = gr[64 * j]; xr[64 * j] = v * rstd * g; }
    }
}

constexpr int N_PHASES = 10;
#ifndef REP_QKV
#define REP_QKV 0
#endif
#ifndef P5_ASM
#define P5_ASM 0
#endif
#ifndef ALIGNV
#define ALIGNV true
#endif
#ifndef SP2V
#define SP2V true
#endif
__global__ void __launch_bounds__(NWAVES * 64, 2) fwd_kernel(Args args) {
    extern __shared__ __attribute__((aligned(16))) unsigned char lds_raw[];
    Frame F;
    F.lds = (LAS unsigned char*)lds_raw;
    F.tid = threadIdx.x; F.lane = F.tid & 63; F.wave = __builtin_amdgcn_readfirstlane(F.tid >> 6);
    F.G = gridDim.x; { const int bx = blockIdx.x; F.vcu = (F.G % 8 == 0) ? (bx % 8) * (F.G / 8) + bx / 8 : bx; }
    unsigned char* ws = args.ws; const In& I = args.in;
    gu32* ctl = (gu32*)(ws + WS_CTL);
    volatile LAS unsigned* MISC = (volatile LAS unsigned*)(F.lds + MISC_OFF);
    for (int u = F.tid; u < (LDS_BYTES - LDSCTL_OFF) / 4; u += NWAVES * 64) ((LAS unsigned*)(F.lds + LDSCTL_OFF))[u] = 0u;
    __syncthreads();
    const int lo = args.ph_lo, hi = args.ph_hi;
    const bool one_phase = (hi - lo) == 1;
    XcdBarrier bar; bar.bar = (unsigned*)(ctl + CW_BAR); bar.x = 0; bar.st = nullptr;
    if (!one_phase) bar = xcd_barrier_post((unsigned*)(ctl + CW_BAR), MISC + 8);
#ifndef ONLY_PHASE
#define ONLY_PHASE -1
#endif
#define IN(k) ((ONLY_PHASE < 0 || ONLY_PHASE == (k)) && lo <= (k) && (k) < hi)
#define SEAM(k) do { if (IN(k) && IN((k) + 1)) xcd_barrier(bar); } while (0)
    float* ssq_cq = (float*)(ws + WS_CTL + CTL_SSQ); float* ssq_ckv = ssq_cq + M; float* ssq1 = ssq_ckv + M; float* ssq2 = ssq1 + M; float* ssq3 = ssq2 + M;
    bf16* XB = (bf16*)(ws + WS_XB); bf16* PJ = (bf16*)(ws + WS_PROJ); bf16* HB = (bf16*)(ws + WS_HB); bf16* ACT = (bf16*)(ws + WS_ACT); bf16* PP = (bf16*)(ws + WS_PP);
    const float* cosR = (const float*)(ws + WS_COSR); const float* sinR = (const float*)(ws + WS_SINR); const float* cosM = (const float*)(ws + WS_COSM); const float* sinM = (const float*)(ws + WS_SINM);

    const int cv_rem = (64 * 7) % F.G;
    if (IN(0)) { p0_prologue(F, I, ws); SEAM(0); }
    if (IN(1)) {
        { pg8::Gemm g{XB, (const bf16*)(ws + WS_WIN), M, 8192, DM, DM, DM}; pg8::StaticOrder S; S.init(M, 8192, F.G, (int)blockIdx.x, 4);
          pg8::EpiProj E{PJ, LDP, cosR, sinR};
          pg8::gemm_phase<pg8::EpiProj, pg8::StaticOrder, ALIGNV, SP2V>(F.lds, g, S, E); }
        { pg8::Gemm8 g{ws + WS_XB8, ws + WS_WIN8, M, 1792, DM, DM, DM}; pg8::StaticOrder S; S.init(M, 1792, F.G, (int)blockIdx.x);
          pg8::EpiC8 E{ws + WS_C8, ws + WS_KR, ssq_cq, ssq_ckv, cosM, sinM};
          pg8::gemm_phase8<pg8::EpiC8, pg8::StaticOrder, true>(F.lds, g, S, E); }
        if (cv_rem == 0) pre_convert(F, I, ws, (int)blockIdx.x, F.G, CV_PRE);
        else if ((int)blockIdx.x >= cv_rem) pre_convert(F, I, ws, (int)blockIdx.x - cv_rem, F.G - cv_rem, CV_PRE);
        SEAM(1);
    }
    if (IN(2)) {
        retention_phase(F, I, ws, CV_PRE);
        { pg8::Gemm8 g{ws + WS_C8, ws + WS_WUQ, M, 3072, 1024, 1536, 1024}; pg8::StaticOrder S; S.init(M, 3072, F.G, (int)blockIdx.x);
          pg8::EpiQ E{ws + WS_Q, ssq_cq, cosM, sinM};
          pg8::gemm_phase8<pg8::EpiQ, pg8::StaticOrder, true>(F.lds, g, S, E); }
        { pg8::Gemm8 g{ws + WS_C8 + 1024, ws + WS_WUKV, M, 4096, 512, 1536, 512}; pg8::StaticOrder S; S.init(M, 4096, F.G, (int)blockIdx.x);
          pg8::EpiKV E{ws + WS_KB, ws + WS_VB, ssq_ckv};
          pg8::gemm_phase8<pg8::EpiKV, pg8::StaticOrder, true>(F.lds, g, S, E); }
#if REP_QKV
        { pg8::Gemm8 g{ws + WS_C8, ws + WS_WUQ, M, 3072, 1024, 1536, 1024}; pg8::StaticOrder S; S.init(M, 3072, F.G, (int)blockIdx.x);
          pg8::EpiQ E{ws + WS_Q, ssq_cq, cosM, sinM};
          pg8::gemm_phase8<pg8::EpiQ, pg8::StaticOrder, true>(F.lds, g, S, E); }
        { pg8::Gemm8 g{ws + WS_C8 + 1024, ws + WS_WUKV, M, 4096, 512, 1536, 512}; pg8::StaticOrder S; S.init(M, 4096, F.G, (int)blockIdx.x);
          pg8::EpiKV E{ws + WS_KB, ws + WS_VB, ssq_ckv};
          pg8::gemm_phase8<pg8::EpiKV, pg8::StaticOrder, true>(F.lds, g, S, E); }
#endif
        SEAM(2);
    }
    if (IN(3)) { ro_finalize(F, ws); attn_phase(F, ws); SEAM(3); }
    if (IN(4)) {
        pg8::Gemm8 g{ws + WS_XB, ws + WS_WO, M, DM, 6144, 6144, 6144}; pg8::StaticOrder S; S.init(M, DM, F.G, (int)blockIdx.x);
        pg8::EpiResT<false> E{I.x, HB, ssq1, nullptr};
        pg8::gemm_phase8<pg8::EpiResT<false>, pg8::StaticOrder, true, 32, 0x79797979, 0x7b7b7b7b>(F.lds, g, S, E);
        SEAM(4);
    }
    if (IN(5)) {
        pg8::StaticOrder S; S.init(M, 22016, F.G, (int)blockIdx.x);
        pg8::EpiGU E{ACT, ssq1, I.conv_w, I.conv_b, (float*)(ws + WS_GT), (float*)(ws + WS_GH), (float*)(ws + WS_UH)};
#if P5_ASM
        { pg8::Gemm8 g{(const unsigned char*)HB, ws + WS_WGU, M, 22016, 2 * DM, 2 * DM, 2 * DM};
          pg8::gemm_phase8<pg8::EpiGU, pg8::StaticOrder, true, 64>(F.lds, g, S, E); }
#else
        { pg8::Gemm g{HB, (const bf16*)(ws + WS_WGU), M, 22016, DM, DM, DM};
          pg8::gemm_phase<pg8::EpiGU, pg8::StaticOrder, ALIGNV, SP2V>(F.lds, g, S, E); }
#endif
        { constexpr int nwg = 64 * 86; const int G = F.G, c = (int)blockIdx.x, rem = nwg % G;
          const int rank = rem == 0 ? c : c - rem, nranks = rem == 0 ? G : G - rem;
          if (rem == 0 || c >= rem) { late_convert(F, I, ws, rank, nranks);
            pg8::Gemm gp{(const bf16*)(ws + WS_PB), (const bf16*)(ws + WS_WPP), M, DM, 256, 256, 256}; pg8::StaticOrder Sp; Sp.init(M, DM, nranks, rank);
            pg8::EpiPlain Ep{PP, DM};
            pg8::gemm_phase<pg8::EpiPlain, pg8::StaticOrder, ALIGNV, SP2V>(F.lds, gp, Sp, Ep); } }
        SEAM(5);
    }
    if (IN(6)) { fixup_phase(F, I, ws); SEAM(6); }
    if (IN(7)) {
        { pg8::Gemm g{ACT, (const bf16*)(ws + WS_WDN), M, DM, NFF, NFF, NFF}; pg8::StaticOrder S; S.init(M, DM, F.G, (int)blockIdx.x);
          pg8::EpiResT<true> E{nullptr, HB, ssq2, ws + WS_H8};
          pg8::gemm_phase<pg8::EpiResT<true>, pg8::StaticOrder, ALIGNV, SP2V>(F.lds, g, S, E); }
        SEAM(7);
    }
    const bool fuse_final = (F.G == 256);
    if (IN(8)) {
        pg8::Gemm8 g{ws + WS_H8, ws + WS_WPG, M, DM, DM, DM, DM};
        if (fuse_final) { pg8::PanelOrder S{(int)blockIdx.x}; pg8::EpiPleFinal E{args.out, HB, PP, ssq2, ssq3, (unsigned*)(ws + WS_CTL + CTL_PCNT), I.g_final};
            pg8::gemm_phase8<pg8::EpiPleFinal, pg8::PanelOrder, true>(F.lds, g, S, E); }
        else { pg8::StaticOrder S; S.init(M, DM, F.G, (int)blockIdx.x); pg8::EpiPle E{args.out, HB, PP, ssq2, ssq3};
            pg8::gemm_phase8<pg8::EpiPle, pg8::StaticOrder, true>(F.lds, g, S, E); SEAM(8); }
    }
    if (IN(9) && !fuse_final) final_norm(F, I, args.out, ssq3);
#undef IN
#undef SEAM
}

#ifndef MK_SPLIT
#define MK_SPLIT 0
#endif
extern "C" void kernel_launch(void* const* d_in, const int* in_sizes, int n_in, void* d_out, int out_size, void* d_ws, size_t ws_size, hipStream_t stream) {
    static int grid = 0;
    if (grid == 0) {
        if (n_in != 19 || out_size != M * DM || ws_size < WS_END) { fprintf(stderr, "kernel_launch: unexpected shapes (n_in %d, out %d, ws %zu)\n", n_in, out_size, ws_size); grid = -1; return; }
        int dev = 0, cus = 0, per_cu = 0;
        if (hipGetDevice(&dev) != hipSuccess || hipDeviceGetAttribute(&cus, hipDeviceAttributeMultiprocessorCount, dev) != hipSuccess) { grid = -1; return; }
        if (hipFuncSetAttribute((const void*)fwd_kernel, hipFuncAttributeMaxDynamicSharedMemorySize, LDS_BYTES) != hipSuccess) { fprintf(stderr, "kernel_launch: hipFuncSetAttribute failed\n"); grid = -1; return; }
        if (hipOccupancyMaxActiveBlocksPerMultiprocessor(&per_cu, (const void*)fwd_kernel, NWAVES * 64, LDS_BYTES) != hipSuccess || per_cu < 1) { fprintf(stderr, "kernel_launch: occupancy query says %d\n", per_cu); }
        (void)hipGetLastError();
        grid = cus;
    }
    if (grid < 0) return;
    if (hipMemsetAsync((char*)d_ws + WS_CTL, 0, CTL_ZERO_BYTES, stream) != hipSuccess) return;
    Args a{};
    const float** ip = (const float**)&a.in;
    for (int i = 0; i < 19; ++i) ip[i] = (const float*)d_in[i];
    a.out = (float*)d_out; a.ws = (unsigned char*)d_ws;
#if MK_SPLIT
    for (int ph = 0; ph < N_PHASES; ++ph) { a.ph_lo = ph; a.ph_hi = ph + 1; hipLaunchKernelGGL(fwd_kernel, dim3(grid), dim3(NWAVES * 64), LDS_BYTES, stream, a); }
#else
    a.ph_lo = 0; a.ph_hi = N_PHASES;
    hipLaunchKernelGGL(fwd_kernel, dim3(grid), dim3(NWAVES * 64), LDS_BYTES, stream, a);
#endif
}
```

```cpp
#include <hip/hip_runtime.h>
#include <cstdio>
#include <cstdint>
namespace pg8 {
#define PG8_LAS __attribute__((address_space(3)))
typedef unsigned short bf16_t;
typedef short bf16x8 __attribute__((ext_vector_type(8)));
typedef float f32x4 __attribute__((ext_vector_type(4)));
typedef unsigned u32x4 __attribute__((ext_vector_type(4)));
constexpr int BM = 256, BK = 64, HALF = 128, HTB = HALF * BK * 2  , STAGE_BYTES = 8 * HTB, NXCD = 8, WGM = 8;

__host__ __device__ __forceinline__ int lds_byte(int r, int c) { const int st = (r >> 4) * 2 + (c >> 5), rr = r & 15, cc = c & 31, ob = rr * 64 + cc * 2; return st * 1024 + (ob ^ (((ob >> 9) & 1) << 5)); }
__host__ __device__ __forceinline__ void stage_rc(int b, int& R, int& C) { const int st = b / 1024, sb = b % 1024, swz = sb ^ (((sb >> 9) & 1) << 5); R = (st >> 1) * 16 + swz / 64; C = (st & 1) * 32 + (swz % 64) / 2; }
__host__ __device__ __forceinline__ int perm32(int rho) { const int n = rho >> 4, i = rho & 15; return 8 * (i >> 2) + 4 * n + (i & 3); }

struct Unit { int pm, pn; };
struct Gemm { const bf16_t* A; const bf16_t* Bt; int M, N, K, lda, ldb; };

struct StaticOrder {
    int nM, nN, nwg, G, c;
    __host__ __device__ void init(int M, int N, int G_, int c_) { nM = M / BM; nN = N / BM; nwg = nM * nN; G = G_; c = c_; }
    __host__ __device__ bool next(int i, Unit& u) const {
        const long L = (long)i * G + c; if (L >= nwg) return false;
        int wgid = (int)L; { const int q = nwg / NXCD, r = nwg % NXCD, xcd = wgid % NXCD, off = wgid / NXCD; wgid = (xcd < r ? xcd * (q + 1) : r * (q + 1) + (xcd - r) * q) + off; }
        const int nig = WGM * nN, gid = wgid / nig, fm = gid * WGM, gsz = (nM - fm) < WGM ? (nM - fm) : WGM;
        u.pm = fm + ((wgid % nig) % gsz); u.pn = (wgid % nig) / gsz; return true;
    }
    __device__ __forceinline__ void a_ready(const Unit&) const {}
    __device__ __forceinline__ void done(const Unit&) const {}
};

typedef float f32x2c_t __attribute__((ext_vector_type(2))); typedef __bf16 bf16x2c_t __attribute__((ext_vector_type(2)));
__device__ __forceinline__ unsigned cvt_pk_bf16(float lo, float hi) { f32x2c_t v = {lo, hi}; bf16x2c_t b = __builtin_convertvector(v, bf16x2c_t); return __builtin_bit_cast(unsigned, b); }
typedef float f32x2 __attribute__((ext_vector_type(2)));

typedef unsigned u32x2 __attribute__((ext_vector_type(2)));
constexpr float RMS_EPS = 1e-6f;
__device__ __forceinline__ u32x4 pack8(const f32x4 a, const f32x4 b) { u32x4 w; w.x = cvt_pk_bf16(a[0], a[1]); w.y = cvt_pk_bf16(a[2], a[3]); w.z = cvt_pk_bf16(b[0], b[1]); w.w = cvt_pk_bf16(b[2], b[3]); return w; }
__device__ __forceinline__ float sumsq4(const f32x4 a) { return (a[0] * a[0] + a[1] * a[1]) + (a[2] * a[2] + a[3] * a[3]); }
__device__ __forceinline__ float quad_row_sum(float s) { s += __shfl_xor(s, 16); s += __shfl_xor(s, 32); return s; }
__device__ __forceinline__ void atomic_add_f32(float* p, float v) { unsafeAtomicAdd(p, v); }
__device__ __forceinline__ float bf_lo(unsigned w) { return __uint_as_float(w << 16); }
__device__ __forceinline__ float bf_hi(unsigned w) { return __uint_as_float(w & 0xffff0000u); }
__device__ __forceinline__ u32x2 pack8_fp8(const f32x4 a, const f32x4 b) {
    int w0 = __builtin_amdgcn_cvt_pk_fp8_f32(a[0], a[1], 0, false); w0 = __builtin_amdgcn_cvt_pk_fp8_f32(a[2], a[3], w0, true);
    int w1 = __builtin_amdgcn_cvt_pk_fp8_f32(b[0], b[1], 0, false); w1 = __builtin_amdgcn_cvt_pk_fp8_f32(b[2], b[3], w1, true);
    u32x2 r; r.x = (unsigned)w0; r.y = (unsigned)w1; return r; }
constexpr float WQ8_SCALE = 32.0f;
constexpr float W8_SCALE = 64.0f;

struct EpiPlain {
    static constexpr bool PERM = true, AFTER_DRAIN = false;
    bf16_t* O; int ldc;
    __device__ __forceinline__ void operator()(const f32x4 (&acc)[2][2][4][2], const Unit& u, int wr, int wc, int fr, int fq) const {
        const int row0 = u.pm * BM + wr * 64 + fr, col0 = u.pn * BM + wc * 32 + 8 * fq;
#pragma unroll
        for (int ai = 0; ai < 2; ++ai)
#pragma unroll
            for (int m = 0; m < 4; ++m) { bf16_t* rowp = O + (size_t)(row0 + ai * HALF + m * 16) * ldc + col0;
#pragma unroll
                for (int bj = 0; bj < 2; ++bj) *(u32x4*)(rowp + bj * HALF) = pack8(acc[ai][bj][m][0], acc[ai][bj][m][1]); }
    }
};

struct EpiProj {
    static constexpr bool PERM = true, AFTER_DRAIN = false;
    bf16_t* P; int ldp; const float* cosR; const float* sinR;
    __device__ __forceinline__ void operator()(const f32x4 (&acc)[2][2][4][2], const Unit& u, int wr, int wc, int fr, int fq) const {
        const int row0 = u.pm * BM + wr * 64 + fr, cl = wc * 32 + 8 * fq, pn = u.pn;
        if (pn < 16) {
            const float sc = pn >= 8 ? 0.0625f : 1.0f;
            constexpr int DEPTH = 3;
            f32x4 tc[8][2], ts[8][2];
#define EPJ_LOAD(g_) do { const int pos_ = (row0 + ((g_) >> 2) * HALF + ((g_) & 3) * 16) & 4095; const float* cp_ = cosR + (size_t)pos_ * 128 + cl; const float* sp_ = sinR + (size_t)pos_ * 128 + cl; \
                tc[g_][0] = *(const f32x4*)cp_; tc[g_][1] = *(const f32x4*)(cp_ + 4); ts[g_][0] = *(const f32x4*)sp_; ts[g_][1] = *(const f32x4*)(sp_ + 4); } while (0)
#pragma unroll
            for (int g = 0; g < DEPTH; ++g) EPJ_LOAD(g);
#pragma unroll
            for (int g = 0; g < 8; ++g) { const int ai = g >> 2, m = g & 3, row = row0 + ai * HALF + m * 16;
                f32x4 o1[2], o2[2];
#pragma unroll
                for (int n = 0; n < 2; ++n) { const f32x4 c = tc[g][n] * sc, s = ts[g][n] * sc; const f32x4 x1 = acc[ai][0][m][n], x2 = acc[ai][1][m][n];
                    o1[n] = x1 * c - x2 * s; o2[n] = x2 * c + x1 * s; }
                bf16_t* rowp = P + (size_t)row * ldp + pn * BM + cl;
                *(u32x4*)(rowp) = pack8(o1[0], o1[1]); *(u32x4*)(rowp + HALF) = pack8(o2[0], o2[1]); asm volatile("" ::: "memory");
                if (g + DEPTH < 8) EPJ_LOAD(g + DEPTH); }
#undef EPJ_LOAD
        } else {
#pragma unroll
            for (int ai = 0; ai < 2; ++ai)
#pragma unroll
                for (int m = 0; m < 4; ++m) { const int row = row0 + ai * HALF + m * 16; bf16_t* rowp = P + (size_t)row * ldp + pn * BM + cl;
                    *(u32x4*)(rowp) = pack8(acc[ai][0][m][0], acc[ai][0][m][1]); *(u32x4*)(rowp + HALF) = pack8(acc[ai][1][m][0], acc[ai][1][m][1]); }
        }
    }
};
__device__ __forceinline__ u32x4 pair16(const u32x2 a, const u32x2 b) {
    auto rx = __builtin_amdgcn_permlane16_swap(a.x, b.x, false, false); auto ry = __builtin_amdgcn_permlane16_swap(a.y, b.y, false, false);
    u32x4 w; w.x = rx[0]; w.y = ry[0]; w.z = rx[1]; w.w = ry[1]; return w; }
struct EpiC8 {
    static constexpr bool PERM = true, AFTER_DRAIN = false;
    unsigned char* C8; unsigned char* krope; float* ssq_cq; float* ssq_ckv; const float* cosM; const float* sinM;
    __device__ __forceinline__ void operator()(const f32x4 (&acc_)[2][2][4][2], const Unit& u, int wr, int wc, int fr, int fq) const {
        const int row0 = u.pm * BM + wr * 64 + fr, cl = wc * 32 + 8 * fq, pn = u.pn; constexpr float inv = 1.0f / W8_SCALE;
        if (pn < 6) {
            float* ssq = pn >= 4 ? ssq_ckv : ssq_cq;
            u32x2 c8p[2] = {};
#pragma unroll
            for (int ai = 0; ai < 2; ++ai)
#pragma unroll
                for (int m = 0; m < 4; ++m) { const int row = row0 + ai * HALF + m * 16; const f32x4 a00 = acc_[ai][0][m][0] * inv, a01 = acc_[ai][0][m][1] * inv, a10 = acc_[ai][1][m][0] * inv, a11 = acc_[ai][1][m][1] * inv;
                    const u32x2 c0 = pack8_fp8(a00, a01), c1 = pack8_fp8(a10, a11);
                    if ((m & 1) == 0) { c8p[0] = c0; c8p[1] = c1; }
                    else { unsigned char* c8 = C8 + (size_t)(row - 16 + 16 * (fq & 1)) * 1536 + pn * BM + cl - 8 * (fq & 1); *(u32x4*)c8 = pair16(c8p[0], c0); *(u32x4*)(c8 + HALF) = pair16(c8p[1], c1); }
                    float s = (sumsq4(a00) + sumsq4(a01)) + (sumsq4(a10) + sumsq4(a11)); s = quad_row_sum(s);
                    if (fq == 0) atomic_add_f32(ssq + row, s); }
        } else if (wc == 0) {
            f32x4 acc[2][2][4][2]; u32x2 krp[2] = {};
#pragma unroll
            for (int ai = 0; ai < 2; ++ai)
#pragma unroll
                for (int bj = 0; bj < 2; ++bj)
#pragma unroll
                    for (int m = 0; m < 4; ++m) { acc[ai][bj][m][0] = acc_[ai][bj][m][0] * inv; acc[ai][bj][m][1] = acc_[ai][bj][m][1] * inv; }

#pragma unroll
            for (int ai = 0; ai < 2; ++ai)
#pragma unroll
                for (int m = 0; m < 4; ++m) { const int row = row0 + ai * HALF + m * 16, pos = row & 4095;
                    const float* cp = cosM + (size_t)pos * 32 + 8 * fq; const float* sp = sinM + (size_t)pos * 32 + 8 * fq;
                    f32x4 o1[2], o2[2];
#pragma unroll
                    for (int n = 0; n < 2; ++n) { const f32x4 c = *(const f32x4*)(cp + 4 * n), s = *(const f32x4*)(sp + 4 * n); const f32x4 x1 = acc[ai][0][m][n], x2 = acc[ai][1][m][n];
                        o1[n] = x1 * c - x2 * s; o2[n] = x2 * c + x1 * s; }
                    unsigned char* rowp = krope + (size_t)row * 64 + 8 * fq;
                    const u32x2 r1 = pack8_fp8(o1[0], o1[1]), r2 = pack8_fp8(o2[0], o2[1]);
                    if ((m & 1) == 0) { krp[0] = r1; krp[1] = r2; }
                    else { unsigned char* rp2 = krope + (size_t)(row - 16 + 16 * (fq & 1)) * 64 + 8 * fq - 8 * (fq & 1); *(u32x4*)rp2 = pair16(krp[0], r1); *(u32x4*)(rp2 + 32) = pair16(krp[1], r2); }
                    asm volatile("" ::: "memory"); }
        }
    }
};

struct EpiQ {
    static constexpr bool PERM = true, AFTER_DRAIN = false;
    unsigned char* Q; const float* ssq; const float* cosM; const float* sinM;
    __device__ __forceinline__ void operator()(const f32x4 (&acc)[2][2][4][2], const Unit& u, int wr, int wc, int fr, int fq) const {
        const int row0 = u.pm * BM + wr * 64 + fr, cl = wc * 32 + 8 * fq, pn = u.pn;
        float sqv[8];
#pragma unroll
        for (int g = 0; g < 8; ++g) sqv[g] = ssq[row0 + (g >> 2) * HALF + (g & 3) * 16];
        u32x2 qrp[2] = {};
        if (pn < 8) {
            const int odd = fq & 1;
#pragma unroll
            for (int ai = 0; ai < 2; ++ai)
#pragma unroll
                for (int mp = 0; mp < 2; ++mp) { const int m0 = 2 * mp, m1 = 2 * mp + 1;
                    const float rs0 = (1.0f / WQ8_SCALE) * __builtin_amdgcn_rsqf(sqv[ai * 4 + m0] * (1.0f / 1024.0f) + RMS_EPS), rs1 = (1.0f / WQ8_SCALE) * __builtin_amdgcn_rsqf(sqv[ai * 4 + m1] * (1.0f / 1024.0f) + RMS_EPS);
                    unsigned char* rowp = Q + (size_t)(row0 + ai * HALF + (m0 + odd) * 16) * 3072 + cl - 8 * odd;
#pragma unroll
                    for (int bj = 0; bj < 2; ++bj) *(u32x4*)(rowp + 192 * (2 * pn + bj)) = pair16(pack8_fp8(acc[ai][bj][m0][0] * rs0, acc[ai][bj][m0][1] * rs0), pack8_fp8(acc[ai][bj][m1][0] * rs1, acc[ai][bj][m1][1] * rs1));
                    asm volatile("" ::: "memory"); }
            return; }
#pragma unroll
        for (int ai = 0; ai < 2; ++ai)
#pragma unroll
            for (int m = 0; m < 4; ++m) { const int row = row0 + ai * HALF + m * 16; const float rs = (1.0f / WQ8_SCALE) * __builtin_amdgcn_rsqf(sqv[ai * 4 + m] * (1.0f / 1024.0f) + RMS_EPS);
                unsigned char* rowp = Q + (size_t)row * 3072;
                if (pn < 8) {
#pragma unroll
                    for (int bj = 0; bj < 2; ++bj) *(u32x2*)(rowp + 192 * (2 * pn + bj) + cl) = pack8_fp8(acc[ai][bj][m][0] * rs, acc[ai][bj][m][1] * rs);
                } else { const int pos = row & 4095, head = 4 * (pn - 8) + wc;
                    const float* cp = cosM + (size_t)pos * 32 + 8 * fq; const float* sp = sinM + (size_t)pos * 32 + 8 * fq;
                    f32x4 o1[2], o2[2];
#pragma unroll
                    for (int n = 0; n < 2; ++n) { const f32x4 c = *(const f32x4*)(cp + 4 * n) * rs, s = *(const f32x4*)(sp + 4 * n) * rs; const f32x4 x1 = acc[ai][0][m][n], x2 = acc[ai][1][m][n];
                        o1[n] = x1 * c - x2 * s; o2[n] = x2 * c + x1 * s; }
                    const u32x2 r1 = pack8_fp8(o1[0], o1[1]), r2 = pack8_fp8(o2[0], o2[1]);
                    if ((m & 1) == 0) { qrp[0] = r1; qrp[1] = r2; }
                    else { unsigned char* rp2 = Q + (size_t)(row - 16 + 16 * (fq & 1)) * 3072 + 192 * head + 128 + 8 * fq - 8 * (fq & 1); *(u32x4*)rp2 = pair16(qrp[0], r1); *(u32x4*)(rp2 + 32) = pair16(qrp[1], r2); } }
                asm volatile("" ::: "memory"); }
    }
};

struct EpiKV {
    static constexpr bool PERM = true, AFTER_DRAIN = false;
    unsigned char* K8; unsigned char* VT8; const float* ssq;
    static __device__ __forceinline__ unsigned quad_xpose(unsigned x, unsigned sel1, unsigned sel2) {
        const unsigned p1 = (unsigned)__builtin_amdgcn_update_dpp(0, (int)x, 0xB1, 0xf, 0xf, true);
        const unsigned y = __builtin_amdgcn_perm(p1, x, sel1);
        const unsigned p2 = (unsigned)__builtin_amdgcn_update_dpp(0, (int)y, 0x4E, 0xf, 0xf, true);
        return __builtin_amdgcn_perm(p2, y, sel2); }
    __device__ __forceinline__ void operator()(const f32x4 (&acc)[2][2][4][2], const Unit& u, int wr, int wc, int fr, int fq) const {
        const int row0 = u.pm * BM + wr * 64 + fr, cl = wc * 32 + 8 * fq, pn = u.pn;
        float sqv[8];
#pragma unroll
        for (int g = 0; g < 8; ++g) sqv[g] = ssq[row0 + (g >> 2) * HALF + (g & 3) * 16];
        const unsigned sel1 = (fr & 1) ? 0x03070105u : 0x06020400u, sel2 = (fr & 2) ? 0x03020706u : 0x05040100u;
        const bool up = (fr & 8) != 0;
        const int rowb = u.pm * BM + wr * 64;
        unsigned char* vbase = VT8 + ((size_t)(((rowb >> 12) * 16 + pn) * 128 + cl + (fr & 3)) << 12) + (rowb & 4095) + 32 * ((fr >> 2) & 1) + 8 * (fr >> 3);
#pragma unroll
        for (int ai = 0; ai < 2; ++ai)
#pragma unroll
            for (int m1 = 0; m1 < 2; ++m1) { unsigned dx[2], dy[2]; u32x2 kq[2];
#pragma unroll
                for (int m0 = 0; m0 < 2; ++m0) { const int m = 2 * m1 + m0, row = row0 + ai * HALF + m * 16; const float rs = (1.0f / WQ8_SCALE) * __builtin_amdgcn_rsqf(sqv[ai * 4 + m] * (1.0f / 512.0f) + RMS_EPS);
                    kq[m0] = pack8_fp8(acc[ai][0][m][0] * rs, acc[ai][0][m][1] * rs);
                    const u32x2 vw = pack8_fp8(acc[ai][1][m][0] * rs, acc[ai][1][m][1] * rs);
                    dx[m0] = quad_xpose(vw.x, sel1, sel2); dy[m0] = quad_xpose(vw.y, sel1, sel2); }
                const unsigned rx = (unsigned)__builtin_amdgcn_update_dpp(0, (int)(up ? dx[0] : dx[1]), 0x128, 0xf, 0xf, true);
                const unsigned ry = (unsigned)__builtin_amdgcn_update_dpp(0, (int)(up ? dy[0] : dy[1]), 0x128, 0xf, 0xf, true);
                u32x2 ox, oy; ox.x = up ? rx : dx[0]; ox.y = up ? dx[1] : rx; oy.x = up ? ry : dy[0]; oy.y = up ? dy[1] : ry;
                *(u32x4*)(K8 + (size_t)(row0 + ai * HALF + (2 * m1 + (fq & 1)) * 16) * 2048 + 128 * pn + cl - 8 * (fq & 1)) = pair16(kq[0], kq[1]);
                unsigned char* vp = vbase + ai * HALF + 16 * m1;
                *(u32x2*)vp = ox; *(u32x2*)(vp + ((size_t)4 << 12)) = oy; }
    }
};

template <bool BASE_BF16, int DEPTH = 4> struct EpiResT {
    static constexpr bool PERM = true, AFTER_DRAIN = false;
    const float* basef; bf16_t* HB; float* ssq; unsigned char* H8;
    __device__ __forceinline__ void operator()(const f32x4 (&acc)[2][2][4][2], const Unit& u, int wr, int wc, int fr, int fq) const {
        const int row0 = u.pm * BM + wr * 64 + fr, col0 = u.pn * BM + wc * 32 + 8 * fq;
        f32x4 b[8][4]; u32x4 bh[8][2]; u32x2 h8p[2] = {};
#define ER_LOAD(g_) do { const size_t off_ = (size_t)(row0 + ((g_) >> 2) * HALF + ((g_) & 3) * 16) * 4096 + col0; \
            if constexpr (BASE_BF16) { bh[g_][0] = *(const u32x4*)(HB + off_); bh[g_][1] = *(const u32x4*)(HB + off_ + HALF); } \
            else { b[g_][0] = *(const f32x4*)(basef + off_); b[g_][1] = *(const f32x4*)(basef + off_ + 4); b[g_][2] = *(const f32x4*)(basef + off_ + HALF); b[g_][3] = *(const f32x4*)(basef + off_ + HALF + 4); } } while (0)
#pragma unroll
        for (int g = 0; g < DEPTH; ++g) ER_LOAD(g);
#pragma unroll
        for (int g = 0; g < 8; ++g) { const int ai = g >> 2, m = g & 3, row = row0 + ai * HALF + m * 16; const size_t off = (size_t)row * 4096 + col0; float s = 0.f;
#pragma unroll
            for (int bj = 0; bj < 2; ++bj) { f32x4 b0, b1;
                if constexpr (BASE_BF16) { const u32x4 w = bh[g][bj]; b0 = (f32x4){bf_lo(w.x), bf_hi(w.x), bf_lo(w.y), bf_hi(w.y)}; b1 = (f32x4){bf_lo(w.z), bf_hi(w.z), bf_lo(w.w), bf_hi(w.w)}; }
                else { b0 = b[g][2 * bj]; b1 = b[g][2 * bj + 1]; }
                const f32x4 v0 = acc[ai][bj][m][0] + b0, v1 = acc[ai][bj][m][1] + b1;
                *(u32x4*)(HB + off + bj * HALF) = pack8(v0, v1);
                if (H8) { const u32x2 h8c = pack8_fp8(v0, v1);
                    if ((g & 1) == 0) h8p[bj] = h8c;
                    else *(u32x4*)(H8 + (size_t)(row - 16 + 16 * (fq & 1)) * 4096 + col0 - 8 * (fq & 1) + bj * HALF) = pair16(h8p[bj], h8c); }
                s += sumsq4(v0) + sumsq4(v1); }
            s = quad_row_sum(s); if (fq == 0) atomic_add_f32(ssq + row, s); asm volatile("" ::: "memory");
            if (g + DEPTH < 8) ER_LOAD(g + DEPTH); }
#undef ER_LOAD
    }
};


struct EpiPle {
    static constexpr bool PERM = true, AFTER_DRAIN = false;
    float* out; const bf16_t* HB; const bf16_t* PP; const float* ssq_in; float* ssq_out;
    __device__ __forceinline__ void operator()(const f32x4 (&acc)[2][2][4][2], const Unit& u, int wr, int wc, int fr, int fq) const {
        const int row0 = u.pm * BM + wr * 64 + fr, col0 = u.pn * BM + wc * 32 + 8 * fq;
#pragma unroll
        for (int ai = 0; ai < 2; ++ai)
#pragma unroll
            for (int m = 0; m < 4; ++m) { const int row = row0 + ai * HALF + m * 16; const size_t off = (size_t)row * 4096 + col0; float s = 0.f;
                const float nrs = (-1.4426950408889634f / W8_SCALE) * __builtin_amdgcn_rsqf(ssq_in[row] * (1.0f / 4096.0f) + RMS_EPS);
#pragma unroll
                for (int bj = 0; bj < 2; ++bj) { const u32x4 hw = *(const u32x4*)(HB + off + bj * HALF); const f32x4 b0 = (f32x4){bf_lo(hw.x), bf_hi(hw.x), bf_lo(hw.y), bf_hi(hw.y)}, b1 = (f32x4){bf_lo(hw.z), bf_hi(hw.z), bf_lo(hw.w), bf_hi(hw.w)}; const u32x4 pw = *(const u32x4*)(PP + off + bj * HALF);
                    f32x4 g0, g1;
#pragma unroll
                    for (int i = 0; i < 4; ++i) { g0[i] = __builtin_amdgcn_rcpf(1.0f + __builtin_amdgcn_exp2f(acc[ai][bj][m][0][i] * nrs)); g1[i] = __builtin_amdgcn_rcpf(1.0f + __builtin_amdgcn_exp2f(acc[ai][bj][m][1][i] * nrs)); }
                    const f32x4 p0 = (f32x4){bf_lo(pw.x), bf_hi(pw.x), bf_lo(pw.y), bf_hi(pw.y)}, p1 = (f32x4){bf_lo(pw.z), bf_hi(pw.z), bf_lo(pw.w), bf_hi(pw.w)};
                    const f32x4 v0 = b0 + g0 * p0, v1 = b1 + g1 * p1;
                    *(f32x4*)(out + off + bj * HALF) = v0; *(f32x4*)(out + off + bj * HALF + 4) = v1; s += sumsq4(v0) + sumsq4(v1); }
                s = quad_row_sum(s); if (fq == 0) atomic_add_f32(ssq_out + row, s); asm volatile("" ::: "memory"); }
    }
};

__device__ __forceinline__ float dpp_shr1z(float src) { return __int_as_float(__builtin_amdgcn_update_dpp(0, __float_as_int(src), 0x111, 0xf, 0xf, true)); }
__device__ __forceinline__ float dpp_shr2z(float src) { return __int_as_float(__builtin_amdgcn_update_dpp(0, __float_as_int(src), 0x112, 0xf, 0xf, true)); }
__device__ __forceinline__ float dpp_ror1(float src) { return __int_as_float(__builtin_amdgcn_update_dpp(0, __float_as_int(src), 0x121, 0xf, 0xf, true)); }
__device__ __forceinline__ float dpp_ror2(float src) { return __int_as_float(__builtin_amdgcn_update_dpp(0, __float_as_int(src), 0x122, 0xf, 0xf, true)); }
struct EpiGU {
    static constexpr bool PERM = true, AFTER_DRAIN = false;
    bf16_t* ACT; const float* ssq; const float* cw; const float* cb; float* GT; float* GH; float* UH;
    __device__ __forceinline__ void operator()(const f32x4 (&acc)[2][2][4][2], const Unit& u, int wr, int wc, int fr, int fq) const {
        const int row0 = u.pm * BM + wr * 64 + fr, f0 = u.pn * HALF + wc * 32 + 8 * fq;
        float sqv[8];
#pragma unroll
        for (int g = 0; g < 8; ++g) sqv[g] = ssq[row0 + (g >> 2) * HALF + (g & 3) * 16];
        f32x4 w0[2], w1[2], w2[2], bb[2], w0m[2], w1m[2];
#pragma unroll
        for (int n = 0; n < 2; ++n) { w0[n] = *(const f32x4*)(cw + f0 + 4 * n); w1[n] = *(const f32x4*)(cw + 11008 + f0 + 4 * n); w2[n] = *(const f32x4*)(cw + 22016 + f0 + 4 * n); bb[n] = *(const f32x4*)(cb + f0 + 4 * n);
            w1m[n] = (fr == 0) ? w1[n] : (f32x4){0.f, 0.f, 0.f, 0.f}; w0m[n] = (fr < 2) ? w0[n] : (f32x4){0.f, 0.f, 0.f, 0.f}; }
#pragma unroll
        for (int ai = 0; ai < 2; ++ai) {
            const int grp = (u.pm * BM + ai * HALF + wr * 64) >> 6;
            f32x4 pg[2] = {(f32x4){0.f, 0.f, 0.f, 0.f}, (f32x4){0.f, 0.f, 0.f, 0.f}};
#pragma unroll
            for (int m = 0; m < 4; ++m) { const int row = row0 + ai * HALF + m * 16; const float rs = __builtin_amdgcn_rsqf(sqv[ai * 4 + m] * (1.0f / 4096.0f) + RMS_EPS);
                f32x4 av[2];
#pragma unroll
                for (int n = 0; n < 2; ++n) { const f32x4 G = acc[ai][0][m][n] * rs, U = acc[ai][1][m][n] * rs; f32x4 r;
#pragma unroll
                    for (int i = 0; i < 4; ++i) { float a = bb[n][i] + w2[n][i] * G[i]; a += w1[n][i] * dpp_shr1z(G[i]); a += w0[n][i] * dpp_shr2z(G[i]);
                        if (m > 0) { a += w1m[n][i] * dpp_ror1(pg[n][i]); a += w0m[n][i] * dpp_ror2(pg[n][i]); }
                        r[i] = a * __builtin_amdgcn_rcpf(1.0f + __builtin_amdgcn_exp2f(-1.4426950408889634f * a)) * U[i]; }
                    av[n] = r; pg[n] = G;
                    if (m == 0 && fr < 2) { *(f32x4*)(GH + ((size_t)grp * 2 + fr) * 11008 + f0 + 4 * n) = G; *(f32x4*)(UH + ((size_t)grp * 2 + fr) * 11008 + f0 + 4 * n) = U; }
                    if (m == 3 && fr >= 14) *(f32x4*)(GT + ((size_t)grp * 2 + (fr - 14)) * 11008 + f0 + 4 * n) = G; }
                *(u32x4*)(ACT + (size_t)row * 11008 + f0) = pack8(av[0], av[1]); }
        }
    }
};

struct PanelOrder {
    int c;
    __device__ __forceinline__ bool next(int i, Unit& u) const { if (i >= 4) return false; const int x = c & 7, j = c >> 3; u.pm = 16 * i + 2 * x + (j >> 4); u.pn = j & 15; return true; }
    __device__ __forceinline__ void a_ready(const Unit&) const {}
    __device__ __forceinline__ void done(const Unit&) const {}
};
struct EpiPleFinal {
    static constexpr bool PERM = true, AFTER_DRAIN = false;
    float* out; const bf16_t* HB; const bf16_t* PP; const float* ssq_in; float* ssq3; unsigned* cnt; const float* gfin;
    __device__ __forceinline__ void operator()(const f32x4 (&acc)[2][2][4][2], const Unit& u, int wr, int wc, int fr, int fq) const {
        const int row0 = u.pm * BM + wr * 64 + fr, col0 = u.pn * BM + wc * 32 + 8 * fq;
        f32x4 h[2][2][4][2];
        constexpr int DEPTH = 4;
        u32x4 bh[8][2]; u32x4 pq[8][2]; float sq[8];
#define EP_LOAD(g_) do { const int row_ = row0 + ((g_) >> 2) * HALF + ((g_) & 3) * 16; const size_t off_ = (size_t)row_ * 4096 + col0; sq[g_] = ssq_in[row_]; \
            bh[g_][0] = *(const u32x4*)(HB + off_); bh[g_][1] = *(const u32x4*)(HB + off_ + HALF); \
            pq[g_][0] = *(const u32x4*)(PP + off_); pq[g_][1] = *(const u32x4*)(PP + off_ + HALF); } while (0)
#pragma unroll
        for (int g = 0; g < DEPTH; ++g) EP_LOAD(g);
#pragma unroll
        for (int g = 0; g < 8; ++g) { const int ai = g >> 2, m = g & 3, row = row0 + ai * HALF + m * 16; float s = 0.f;
            const float nrs = (-1.4426950408889634f / W8_SCALE) * __builtin_amdgcn_rsqf(sq[g] * (1.0f / 4096.0f) + RMS_EPS);
#pragma unroll
            for (int bj = 0; bj < 2; ++bj) { const u32x4 pw = pq[g][bj];
                f32x4 g0, g1;
#pragma unroll
                for (int i = 0; i < 4; ++i) { g0[i] = __builtin_amdgcn_rcpf(1.0f + __builtin_amdgcn_exp2f(acc[ai][bj][m][0][i] * nrs)); g1[i] = __builtin_amdgcn_rcpf(1.0f + __builtin_amdgcn_exp2f(acc[ai][bj][m][1][i] * nrs)); }
                const f32x4 p0 = (f32x4){bf_lo(pw.x), bf_hi(pw.x), bf_lo(pw.y), bf_hi(pw.y)}, p1 = (f32x4){bf_lo(pw.z), bf_hi(pw.z), bf_lo(pw.w), bf_hi(pw.w)};
                const u32x4 hw = bh[g][bj]; const f32x4 b0 = (f32x4){bf_lo(hw.x), bf_hi(hw.x), bf_lo(hw.y), bf_hi(hw.y)}, b1 = (f32x4){bf_lo(hw.z), bf_hi(hw.z), bf_lo(hw.w), bf_hi(hw.w)};
                const f32x4 v0 = b0 + g0 * p0, v1 = b1 + g1 * p1;
                h[ai][bj][m][0] = v0; h[ai][bj][m][1] = v1; s += sumsq4(v0) + sumsq4(v1); }
            s = quad_row_sum(s); if (fq == 0) atomic_add_f32(ssq3 + row, s); asm volatile("" ::: "memory");
            if (g + DEPTH < 8) EP_LOAD(g + DEPTH); }
#undef EP_LOAD
        asm volatile("s_waitcnt vmcnt(0)" ::: "memory");
        unsigned* cw = cnt + 64 * u.pm;
        if ((threadIdx.x & 63) == 0) __hip_atomic_fetch_add(cw, 1u, __ATOMIC_RELAXED, __HIP_MEMORY_SCOPE_AGENT);
        if (threadIdx.x < 64) { unsigned spins = 0;
            while ((unsigned)__builtin_amdgcn_readfirstlane(__hip_atomic_load(cw, __ATOMIC_RELAXED, __HIP_MEMORY_SCOPE_AGENT)) < 128u) { __builtin_amdgcn_s_sleep(2); if (++spins > (1u << 22)) break; }
            asm volatile("s_waitcnt vmcnt(0)" ::: "memory"); }
        asm volatile("" ::: "memory"); __builtin_amdgcn_s_barrier(); asm volatile("" ::: "memory");
        float s3[8]; f32x4 gf[2][2];
#pragma unroll
        for (int g = 0; g < 8; ++g) s3[g] = __hip_atomic_load(ssq3 + row0 + (g >> 2) * HALF + (g & 3) * 16, __ATOMIC_RELAXED, __HIP_MEMORY_SCOPE_AGENT);
#pragma unroll
        for (int bj = 0; bj < 2; ++bj) { gf[bj][0] = *(const f32x4*)(gfin + col0 + bj * HALF); gf[bj][1] = *(const f32x4*)(gfin + col0 + bj * HALF + 4); }
#pragma unroll
        for (int ai = 0; ai < 2; ++ai)
#pragma unroll
            for (int m = 0; m < 4; ++m) { const int row = row0 + ai * HALF + m * 16; const size_t off = (size_t)row * 4096 + col0;
                const float rs = __builtin_amdgcn_rsqf(s3[ai * 4 + m] * (1.0f / 4096.0f) + RMS_EPS);
#pragma unroll
                for (int bj = 0; bj < 2; ++bj) { *(f32x4*)(out + off + bj * HALF) = h[ai][bj][m][0] * (gf[bj][0] * rs); *(f32x4*)(out + off + bj * HALF + 4) = h[ai][bj][m][1] * (gf[bj][1] * rs); } }
    }
};
template <class Epi, class Sched, bool ALIGN_EPI = false, bool SP2 = false>
__device__ __forceinline__ void gemm_phase(PG8_LAS unsigned char* lds, const Gemm g, const Sched& S, const Epi& E) {
    const int tid = threadIdx.x, wid = __builtin_amdgcn_readfirstlane(tid >> 6), lane = tid & 63, wr = wid >> 2, wc = wid & 3, fr = lane & 15, fq = lane >> 4;
    int K = g.K; asm volatile("" : "+s"(K));
    const int nt = K / BK;
    unsigned voffA[2], voffB[2];
#pragma unroll
    for (int i = 0; i < 2; ++i) { int R, C; stage_rc(tid * 16 + i * 8192, R, C); const int Rb = Epi::PERM ? ((R & ~31) + perm32(R & 31)) : R;
        voffA[i] = (unsigned)(R * g.lda + C) * 2u; voffB[i] = (unsigned)(Rb * g.ldb + C) * 2u; }
    const size_t kstep = (size_t)(BK * 2);
    const size_t hstepA = (size_t)HALF * g.lda * 2, hstepB = (size_t)HALF * g.ldb * 2;
    const size_t tstepA = 2 * hstepA, tstepB = 2 * hstepB;
    const unsigned ldsw = (unsigned)wid * 1024u;
    const int aoff = lds_byte(wr * 64 + fr, fq * 8), boff = lds_byte(wc * 32 + fr, fq * 8);
#define PG8_SA(b, h) (((b) * 2 + (h)) * HTB)
#define PG8_SB(b, h) ((4 + (b) * 2 + (h)) * HTB)
#ifndef PG8_B_AUX
#define PG8_B_AUX 0
#endif
#define PG8_STAGE(bufoff, gbase, voff) do { _Pragma("unroll") for (int _i = 0; _i < 2; ++_i) { \
        if ((bufoff) >= 4 * HTB) __builtin_amdgcn_global_load_lds((const unsigned*)((const char*)(gbase) + (voff)[_i]), (PG8_LAS unsigned*)(lds + (bufoff) + ldsw + _i * 8192), 16, 0, PG8_B_AUX); \
        else __builtin_amdgcn_global_load_lds((const unsigned*)((const char*)(gbase) + (voff)[_i]), (PG8_LAS unsigned*)(lds + (bufoff) + ldsw + _i * 8192), 16, 0, 0); } } while (0)
#define PG8_LDA(dst, b, h) do { _Pragma("unroll") for (int m = 0; m < 4; ++m) _Pragma("unroll") for (int k = 0; k < 2; ++k) dst[m][k] = *(const PG8_LAS bf16x8*)(lds + PG8_SA(b, h) + aoff + m * 2048 + k * 1024); } while (0)
#define PG8_LDB(dst, b, h) do { _Pragma("unroll") for (int n = 0; n < 2; ++n) _Pragma("unroll") for (int k = 0; k < 2; ++k) dst[n][k] = *(const PG8_LAS bf16x8*)(lds + PG8_SB(b, h) + boff + n * 2048 + k * 1024); } while (0)
#define PG8_MMA(ai, bj, At, Bt) do { __builtin_amdgcn_s_setprio(1); _Pragma("unroll") for (int m = 0; m < 4; ++m) _Pragma("unroll") for (int n = 0; n < 2; ++n) _Pragma("unroll") for (int k = 0; k < 2; ++k) \
        acc[ai][bj][m][n] = __builtin_amdgcn_mfma_f32_16x16x32_bf16(Bt[n][k], At[m][k], acc[ai][bj][m][n], 0, 0, 0); __builtin_amdgcn_s_setprio(0); } while (0)
#define PG8_WAIT_V(n) asm volatile("s_waitcnt vmcnt(" #n ")" ::: "memory")
#define PG8_WAIT_L(n) asm volatile("s_waitcnt lgkmcnt(" #n ")" ::: "memory")
#define PG8_BAR __builtin_amdgcn_s_barrier()
#define PG8_SCHED __builtin_amdgcn_sched_barrier(0)
    Unit cur, nxt; int ui = 0;
    if (!S.next(0, cur)) return;
    f32x4 acc[2][2][4][2];
#pragma unroll
    for (int a = 0; a < 2; ++a)
#pragma unroll
        for (int b = 0; b < 2; ++b)
#pragma unroll
            for (int m = 0; m < 4; ++m)
#pragma unroll
                for (int n = 0; n < 2; ++n) acc[a][b][m][n] = (f32x4){0.f, 0.f, 0.f, 0.f};
    bf16x8 At[4][2], B0[2][2], B1[2][2];
    const char* cA = (const char*)g.A + (size_t)cur.pm * tstepA; const char* cB = (const char*)g.Bt + (size_t)cur.pn * tstepB;
    S.a_ready(cur);
    if constexpr (SP2) {
        PG8_STAGE(PG8_SB(0, 0), cB, voffB); PG8_STAGE(PG8_SB(0, 1), cB + hstepB, voffB); PG8_STAGE(PG8_SA(0, 0), cA, voffA); PG8_STAGE(PG8_SA(0, 1), cA + hstepA, voffA);
        if (wr == 1) PG8_BAR;
        PG8_WAIT_V(2); PG8_BAR;
        PG8_STAGE(PG8_SB(1, 0), cB + kstep, voffB); PG8_STAGE(PG8_SA(1, 0), cA + kstep, voffA); PG8_STAGE(PG8_SB(1, 1), cB + hstepB + kstep, voffB);
        PG8_WAIT_V(6); PG8_BAR;
    } else {
        PG8_STAGE(PG8_SB(0, 0), cB, voffB); PG8_STAGE(PG8_SA(0, 0), cA, voffA); PG8_STAGE(PG8_SB(0, 1), cB + hstepB, voffB); PG8_STAGE(PG8_SA(0, 1), cA + hstepA, voffA);
        if (wr == 1) PG8_BAR;
        PG8_WAIT_V(4); PG8_BAR;
        PG8_STAGE(PG8_SB(1, 0), cB + kstep, voffB); PG8_STAGE(PG8_SA(1, 0), cA + kstep, voffA); PG8_STAGE(PG8_SB(1, 1), cB + hstepB + kstep, voffB);
        PG8_WAIT_V(6); PG8_BAR;
    }
    for (;;) {
        const bool has_next = S.next(ui + 1, nxt);
        const char* nA = has_next ? (const char*)g.A + (size_t)nxt.pm * tstepA : cA; const char* nB = has_next ? (const char*)g.Bt + (size_t)nxt.pn * tstepB : cB;
        for (int t = 0; t < nt; t += 2) {
            const bool last = (t == nt - 2);
            const char* a1 = cA + (size_t)(t + 1) * kstep;
            const char* a2 = last ? nA : cA + (size_t)(t + 2) * kstep; const char* b2 = last ? nB : cB + (size_t)(t + 2) * kstep;
            const char* a3 = a2 + kstep; const char* b3 = b2 + kstep;
            if (last && has_next) S.a_ready(nxt);
            if constexpr (SP2) {
            PG8_LDB(B0, 0, 0); PG8_LDB(B1, 0, 1); PG8_SCHED; PG8_LDA(At, 0, 0); PG8_STAGE(PG8_SA(1, 1), a1 + hstepA, voffA);
            PG8_WAIT_V(8); PG8_WAIT_L(0); PG8_BAR; PG8_MMA(0, 0, At, B0); PG8_MMA(0, 1, At, B1); PG8_BAR; PG8_SCHED;
            PG8_LDA(At, 0, 1); PG8_STAGE(PG8_SB(0, 0), b2, voffB); PG8_STAGE(PG8_SB(0, 1), b2 + hstepB, voffB); PG8_STAGE(PG8_SA(0, 0), a2, voffA);
            PG8_WAIT_V(8); PG8_WAIT_L(0); PG8_BAR; PG8_MMA(1, 0, At, B0); PG8_MMA(1, 1, At, B1); PG8_BAR; PG8_SCHED;
            PG8_LDB(B0, 1, 0); PG8_LDB(B1, 1, 1); PG8_SCHED; PG8_LDA(At, 1, 0); PG8_STAGE(PG8_SA(0, 1), a2 + hstepA, voffA);
            PG8_WAIT_V(8); PG8_WAIT_L(0); PG8_BAR; PG8_MMA(0, 0, At, B0); PG8_MMA(0, 1, At, B1); PG8_BAR; PG8_SCHED;
            PG8_LDA(At, 1, 1); PG8_STAGE(PG8_SB(1, 0), b3, voffB); PG8_STAGE(PG8_SB(1, 1), b3 + hstepB, voffB); PG8_STAGE(PG8_SA(1, 0), a3, voffA);
            PG8_WAIT_V(8); PG8_WAIT_L(0); PG8_BAR; PG8_MMA(1, 0, At, B0); PG8_MMA(1, 1, At, B1); PG8_BAR; PG8_SCHED;
            } else {
            PG8_LDB(B0, 0, 0); PG8_SCHED; PG8_LDA(At, 0, 0); PG8_STAGE(PG8_SA(1, 1), a1 + hstepA, voffA);
            PG8_WAIT_L(8); PG8_BAR; PG8_WAIT_L(0); PG8_MMA(0, 0, At, B0); PG8_BAR; PG8_SCHED;
            PG8_LDB(B1, 0, 1); PG8_STAGE(PG8_SB(0, 0), b2, voffB);
            PG8_BAR; PG8_WAIT_L(0); PG8_MMA(0, 1, At, B1); PG8_BAR;
            PG8_LDA(At, 0, 1); PG8_STAGE(PG8_SA(0, 0), a2, voffA);
            PG8_BAR; PG8_WAIT_L(0); PG8_MMA(1, 0, At, B0); PG8_BAR; PG8_SCHED;
            PG8_STAGE(PG8_SB(0, 1), b2 + hstepB, voffB);
            PG8_WAIT_V(6); PG8_BAR; PG8_MMA(1, 1, At, B1); PG8_BAR;
            PG8_LDB(B0, 1, 0); PG8_SCHED; PG8_LDA(At, 1, 0); PG8_STAGE(PG8_SA(0, 1), a2 + hstepA, voffA);
            PG8_WAIT_L(8); PG8_BAR; PG8_WAIT_L(0); PG8_MMA(0, 0, At, B0); PG8_BAR; PG8_SCHED;
            PG8_LDB(B1, 1, 1); PG8_STAGE(PG8_SB(1, 0), b3, voffB);
            PG8_BAR; PG8_WAIT_L(0); PG8_MMA(0, 1, At, B1); PG8_BAR;
            PG8_LDA(At, 1, 1); PG8_STAGE(PG8_SA(1, 0), a3, voffA);
            PG8_BAR; PG8_WAIT_L(0); PG8_MMA(1, 0, At, B0); PG8_BAR; PG8_SCHED;
            PG8_STAGE(PG8_SB(1, 1), b3 + hstepB, voffB);
            PG8_WAIT_V(6); PG8_BAR; PG8_MMA(1, 1, At, B1); PG8_BAR;
            }
        }
        if constexpr (ALIGN_EPI) { if (wr == 0) PG8_BAR; }
        if constexpr (!Epi::AFTER_DRAIN) { E(acc, cur, wr, wc, fr, fq); S.done(cur); }
        if (!has_next) break;
#pragma unroll
        for (int a = 0; a < 2; ++a)
#pragma unroll
            for (int b = 0; b < 2; ++b)
#pragma unroll
                for (int m = 0; m < 4; ++m)
#pragma unroll
                    for (int n = 0; n < 2; ++n) acc[a][b][m][n] = (f32x4){0.f, 0.f, 0.f, 0.f};
        cur = nxt; cA = nA; cB = nB; ++ui;
        if constexpr (ALIGN_EPI) { if (wr == 1) PG8_BAR; }
    }
    PG8_WAIT_V(0);
    if constexpr (!ALIGN_EPI) { if (wr == 0) PG8_BAR; }
    PG8_BAR;
    if constexpr (Epi::AFTER_DRAIN) { E.fused(acc, cur, wr, wc, fr, fq, lds, wid, lane); S.done(cur); }
#undef PG8_SA
#undef PG8_SB
#undef PG8_STAGE
#undef PG8_LDA
#undef PG8_LDB
#undef PG8_MMA
#undef PG8_WAIT_V
#undef PG8_WAIT_L
#undef PG8_BAR
#undef PG8_SCHED
}
struct Gemm8 { const unsigned char* A; const unsigned char* Bt; int M, N, K, lda, ldb; };
typedef int v8i32 __attribute__((ext_vector_type(8)));
typedef int v4i32 __attribute__((ext_vector_type(4)));
template <class Epi, class Sched, bool ALIGN_EPI = true, int NTB = 0, int WSC = 0x7f7f7f7f, int ASC = 0x7f7f7f7f>
__device__ __forceinline__ void gemm_phase8(PG8_LAS unsigned char* lds, const Gemm8 g, const Sched& S, const Epi& E) {
    constexpr bool SP2 = true;
    const int tid = threadIdx.x, wid = __builtin_amdgcn_readfirstlane(tid >> 6), lane = tid & 63, wr = wid >> 2, wc = wid & 3, fr = lane & 15, fq = lane >> 4;
    int K = g.K; asm volatile("" : "+s"(K));
    const int nt = K / 128;
    unsigned voffA[2], voffB[2];
#pragma unroll
    for (int i = 0; i < 2; ++i) { int R, C; stage_rc(tid * 16 + i * 8192, R, C); const int Rb = Epi::PERM ? ((R & ~31) + perm32(R & 31)) : R;
        voffA[i] = (unsigned)(R * g.lda + 2 * C); voffB[i] = (unsigned)(Rb * g.ldb + 2 * C); }
    const size_t kstep = (size_t)(BK * 2);
    const size_t hstepA = (size_t)HALF * g.lda, hstepB = (size_t)HALF * g.ldb;
    const size_t tstepA = 2 * hstepA, tstepB = 2 * hstepB;
    const unsigned ldsw = (unsigned)wid * 1024u;
    const int aoffb = lds_byte(wr * 64 + fr, fq * 8), boffb = lds_byte(wc * 32 + fr, fq * 8);
    const int aoff0 = lds_byte(wr * 64 + fr, 16 * fq), aoff1 = lds_byte(wr * 64 + fr, 16 * fq + 8), boff0 = lds_byte(wc * 32 + fr, 16 * fq), boff1 = lds_byte(wc * 32 + fr, 16 * fq + 8);
#define PG8_SA(b, h) (((b) * 2 + (h)) * HTB)
#define PG8_SB(b, h) ((4 + (b) * 2 + (h)) * HTB)
#define PG8_STAGE(bufoff, gbase, voff) do { _Pragma("unroll") for (int _i = 0; _i < 2; ++_i) \
        __builtin_amdgcn_global_load_lds((const unsigned*)((const char*)(gbase) + (voff)[_i]), (PG8_LAS unsigned*)(lds + (bufoff) + ldsw + _i * 8192), 16, 0, 0); } while (0)
#define PG8_LDA(dst, b, h) do { const int o0_ = isb ? aoffb : aoff0, o1_ = isb ? aoffb + 1024 : aoff1; _Pragma("unroll") for (int m = 0; m < 4; ++m) { dst[m].lo = *(const PG8_LAS v4i32*)(lds + PG8_SA(b, h) + o0_ + m * 2048); dst[m].hi = *(const PG8_LAS v4i32*)(lds + PG8_SA(b, h) + o1_ + m * 2048); } } while (0)
#define PG8_LDB(dst, b, h) do { const int o0_ = isb ? boffb : boff0, o1_ = isb ? boffb + 1024 : boff1; _Pragma("unroll") for (int n = 0; n < 2; ++n) { dst[n].lo = *(const PG8_LAS v4i32*)(lds + PG8_SB(b, h) + o0_ + n * 2048); dst[n].hi = *(const PG8_LAS v4i32*)(lds + PG8_SB(b, h) + o1_ + n * 2048); } } while (0)
#define PG8_MMA(ai, bj, At, Bt) do { __builtin_amdgcn_s_setprio(1); \
        if (NTB > 0 && isb) { _Pragma("unroll") for (int m = 0; m < 4; ++m) _Pragma("unroll") for (int n = 0; n < 2; ++n) asm volatile("v_mfma_f32_16x16x32_bf16 %0, %1, %2, %0" : "+v"(acc[ai][bj][m][n]) : "v"(Bt[n].lo), "v"(At[m].lo)); \
            _Pragma("unroll") for (int m = 0; m < 4; ++m) _Pragma("unroll") for (int n = 0; n < 2; ++n) asm volatile("v_mfma_f32_16x16x32_bf16 %0, %1, %2, %0" : "+v"(acc[ai][bj][m][n]) : "v"(Bt[n].hi), "v"(At[m].hi)); } \
        else { _Pragma("unroll") for (int m = 0; m < 4; ++m) _Pragma("unroll") for (int n = 0; n < 2; ++n) \
            asm volatile("v_mfma_scale_f32_16x16x128_f8f6f4 %0, %1, %2, %0, %3, %4 op_sel_hi:[0,0,0]" : "+v"(acc[ai][bj][m][n]) : "v"(Bt[n]), "v"(At[m]), "v"(w_scale), "v"(a_scale)); } \
        __builtin_amdgcn_s_setprio(0); } while (0)
#define PG8_MFMA_DRAIN() asm volatile("s_nop 15\n\ts_nop 15\n\ts_nop 15\n\ts_nop 15\n\ts_nop 15\n\ts_nop 15" ::: "memory")
#define PG8_WAIT_V(n) asm volatile("s_waitcnt vmcnt(" #n ")" ::: "memory")
#define PG8_WAIT_L(n) asm volatile("s_waitcnt lgkmcnt(" #n ")" ::: "memory")
#define PG8_BAR __builtin_amdgcn_s_barrier()
#define PG8_SCHED __builtin_amdgcn_sched_barrier(0)
    Unit cur, nxt; int ui = 0;
    if (!S.next(0, cur)) return;
    f32x4 acc[2][2][4][2];
#pragma unroll
    for (int a = 0; a < 2; ++a)
#pragma unroll
        for (int b = 0; b < 2; ++b)
#pragma unroll
            for (int m = 0; m < 4; ++m)
#pragma unroll
                for (int n = 0; n < 2; ++n) acc[a][b][m][n] = (f32x4){0.f, 0.f, 0.f, 0.f};
    v8i32 At[4], B0[2], B1[2]; const int w_scale = WSC, a_scale = ASC;
    const char* cA = (const char*)g.A + (size_t)cur.pm * tstepA; const char* cB = (const char*)g.Bt + (size_t)cur.pn * tstepB;
    S.a_ready(cur);
    if constexpr (SP2) {
        PG8_STAGE(PG8_SB(0, 0), cB, voffB); PG8_STAGE(PG8_SB(0, 1), cB + hstepB, voffB); PG8_STAGE(PG8_SA(0, 0), cA, voffA); PG8_STAGE(PG8_SA(0, 1), cA + hstepA, voffA);
        if (wr == 1) PG8_BAR;
        PG8_WAIT_V(2); PG8_BAR;
        PG8_STAGE(PG8_SB(1, 0), cB + kstep, voffB); PG8_STAGE(PG8_SA(1, 0), cA + kstep, voffA); PG8_STAGE(PG8_SB(1, 1), cB + hstepB + kstep, voffB);
        PG8_WAIT_V(6); PG8_BAR;
    } else {
        PG8_STAGE(PG8_SB(0, 0), cB, voffB); PG8_STAGE(PG8_SA(0, 0), cA, voffA); PG8_STAGE(PG8_SB(0, 1), cB + hstepB, voffB); PG8_STAGE(PG8_SA(0, 1), cA + hstepA, voffA);
        if (wr == 1) PG8_BAR;
        PG8_WAIT_V(4); PG8_BAR;
        PG8_STAGE(PG8_SB(1, 0), cB + kstep, voffB); PG8_STAGE(PG8_SA(1, 0), cA + kstep, voffA); PG8_STAGE(PG8_SB(1, 1), cB + hstepB + kstep, voffB);
        PG8_WAIT_V(6); PG8_BAR;
    }
#define PG8_KSTEP(ISB) do { constexpr bool isb = ISB; const bool last = (t == nt - 2); \
            const char* a1 = cA + (size_t)(t + 1) * kstep; \
            const char* a2 = last ? nA : cA + (size_t)(t + 2) * kstep; const char* b2 = last ? nB : cB + (size_t)(t + 2) * kstep; \
            const char* a3 = a2 + kstep; const char* b3 = b2 + kstep; \
            if (last && has_next) S.a_ready(nxt); \
            PG8_LDB(B0, 0, 0); PG8_LDB(B1, 0, 1); PG8_SCHED; PG8_LDA(At, 0, 0); PG8_STAGE(PG8_SA(1, 1), a1 + hstepA, voffA); \
            PG8_WAIT_V(8); PG8_WAIT_L(0); PG8_BAR; PG8_MMA(0, 0, At, B0); PG8_MMA(0, 1, At, B1); PG8_BAR; PG8_SCHED; \
            PG8_LDA(At, 0, 1); PG8_STAGE(PG8_SB(0, 0), b2, voffB); PG8_STAGE(PG8_SB(0, 1), b2 + hstepB, voffB); PG8_STAGE(PG8_SA(0, 0), a2, voffA); \
            PG8_WAIT_V(8); PG8_WAIT_L(0); PG8_BAR; PG8_MMA(1, 0, At, B0); PG8_MMA(1, 1, At, B1); PG8_BAR; PG8_SCHED; \
            PG8_LDB(B0, 1, 0); PG8_LDB(B1, 1, 1); PG8_SCHED; PG8_LDA(At, 1, 0); PG8_STAGE(PG8_SA(0, 1), a2 + hstepA, voffA); \
            PG8_WAIT_V(8); PG8_WAIT_L(0); PG8_BAR; PG8_MMA(0, 0, At, B0); PG8_MMA(0, 1, At, B1); PG8_BAR; PG8_SCHED; \
            PG8_LDA(At, 1, 1); PG8_STAGE(PG8_SB(1, 0), b3, voffB); PG8_STAGE(PG8_SB(1, 1), b3 + hstepB, voffB); PG8_STAGE(PG8_SA(1, 0), a3, voffA); \
            PG8_WAIT_V(8); PG8_WAIT_L(0); PG8_BAR; PG8_MMA(1, 0, At, B0); PG8_MMA(1, 1, At, B1); PG8_BAR; PG8_SCHED; } while (0)
    for (;;) {
        const bool has_next = S.next(ui + 1, nxt);
        const char* nA = has_next ? (const char*)g.A + (size_t)nxt.pm * tstepA : cA; const char* nB = has_next ? (const char*)g.Bt + (size_t)nxt.pn * tstepB : cB;
        { int t = 0;
          if constexpr (NTB > 0) { for (; t < NTB; t += 2) PG8_KSTEP(true); }
          for (; t < nt; t += 2) PG8_KSTEP(false); }
        if constexpr (ALIGN_EPI) { if (wr == 0) PG8_BAR; }
        PG8_MFMA_DRAIN();
        if constexpr (!Epi::AFTER_DRAIN) { E(acc, cur, wr, wc, fr, fq); S.done(cur); }
        if (!has_next) break;
#pragma unroll
        for (int a = 0; a < 2; ++a)
#pragma unroll
            for (int b = 0; b < 2; ++b)
#pragma unroll
                for (int m = 0; m < 4; ++m)
#pragma unroll
                    for (int n = 0; n < 2; ++n) acc[a][b][m][n] = (f32x4){0.f, 0.f, 0.f, 0.f};
        cur = nxt; cA = nA; cB = nB; ++ui;
        if constexpr (ALIGN_EPI) { if (wr == 1) PG8_BAR; }
    }
    PG8_WAIT_V(0);
    if constexpr (!ALIGN_EPI) { if (wr == 0) PG8_BAR; }
    PG8_BAR;
    if constexpr (Epi::AFTER_DRAIN) { E.fused(acc, cur, wr, wc, fr, fq, lds, wid, lane); S.done(cur); }
#undef PG8_SA
#undef PG8_SB
#undef PG8_STAGE
#undef PG8_LDA
#undef PG8_LDB
#undef PG8_MMA
#undef PG8_KSTEP
#undef PG8_MFMA_DRAIN
#undef PG8_WAIT_V
#undef PG8_WAIT_L
#undef PG8_BAR
#undef PG8_SCHED
}
}

constexpr int NWAVES = 8;
constexpr int NB = 4, SEQ = 4096, M = NB * SEQ, DM = 4096, NFF = 11008, LDP = 9984  ;
constexpr int NGRP = M / 64;
constexpr size_t MiB = 1u << 20;
constexpr size_t WS_CTL = 0, CTL_ZERO_BYTES = 1 * MiB;
constexpr int CW_BAR = 4096;
constexpr size_t CTL_SSQ = 256 * 1024;
constexpr size_t CTL_PCNT = 64 * 1024;
constexpr size_t WS_COSM = 1 * MiB + 512 * 1024, WS_SINM = 2 * MiB, WS_COSR = 3 * MiB, WS_SINR = 5 * MiB;
constexpr size_t WS_PB = 8 * MiB;
constexpr size_t WS_KR = 16 * MiB;
constexpr size_t WS_STATS = 18 * MiB;
constexpr size_t WS_WIN = 32 * MiB, WS_WUQ = 110 * MiB, WS_WUKV = 116 * MiB, WS_WO = 120 * MiB, WS_WGU = 152 * MiB;
constexpr size_t WS_PP = 18 * MiB;
constexpr size_t WS_XB = 324 * MiB;
constexpr size_t WS_WDN = 324 * MiB, WS_WPG = 410 * MiB, WS_WPP = 1016 * MiB;
constexpr size_t WS_PROJ = 452 * MiB;
constexpr size_t WS_HB = 452 * MiB;
constexpr size_t WS_ACT = 580 * MiB;
constexpr size_t WS_Q = 764 * MiB, WS_KB = 860 * MiB, WS_VB = 924 * MiB;
constexpr size_t WS_GT = 924 * MiB, WS_GH = 946 * MiB, WS_UH = 968 * MiB;
constexpr size_t WS_H8 = 924 * MiB;
constexpr size_t WS_WIN8 = 96 * MiB;
constexpr size_t WS_XB8 = 764 * MiB;
constexpr size_t WS_C8 = 992 * MiB;
constexpr size_t WS_END = 1018 * MiB;
static_assert(WS_ACT + (size_t)M * NFF * 2 <= WS_GT && WS_UH + (size_t)NGRP * 2 * NFF * 4 <= WS_END && WS_WGU + (size_t)22016 * 4096 * 2 <= WS_XB && WS_PROJ + (size_t)M * LDP * 2 <= WS_Q, "d_ws map");

constexpr int CCP = 3072;
constexpr float MO8_SCALE = 16.0f;
constexpr int RING_BYTES = 131072, LDSCTL_OFF = RING_BYTES, MISC_OFF = LDSCTL_OFF + 320, LDS_BYTES = 147456;

#define GAS __attribute__((address_space(1)))
#define LAS __attribute__((address_space(3)))
typedef unsigned short bf16;
typedef unsigned v4u __attribute__((ext_vector_type(4)));
typedef unsigned v2u __attribute__((ext_vector_type(2)));
typedef float f32x4 __attribute__((ext_vector_type(4)));
typedef float f32x16 __attribute__((ext_vector_type(16)));
typedef short bf16x8 __attribute__((ext_vector_type(8)));
typedef short s16x4 __attribute__((ext_vector_type(4)));
typedef GAS unsigned gu32;
#define RLX_AGENT __ATOMIC_RELAXED, __HIP_MEMORY_SCOPE_AGENT
#define LDS_WAIT() asm volatile("s_waitcnt lgkmcnt(0)" ::: "memory")
#define VM_WAIT() asm volatile("s_waitcnt vmcnt(0)" ::: "memory")
#define SBAR() __builtin_amdgcn_sched_barrier(0)
__device__ __forceinline__ unsigned cvtpk(float lo, float hi) { return pg8::cvt_pk_bf16(lo, hi); }
__device__ __forceinline__ float bflo(unsigned w) { return __uint_as_float(w << 16); }
__device__ __forceinline__ float bfhi(unsigned w) { return __uint_as_float(w & 0xffff0000u); }
__device__ __forceinline__ int crow(int r, int hi) { return (r & 3) + 8 * (r >> 2) + 4 * hi; }
__device__ __forceinline__ s16x4 tr_read(const LAS unsigned char* p) { typedef short v4i16_t __attribute__((ext_vector_type(4))); return __builtin_bit_cast(s16x4, __builtin_amdgcn_ds_read_tr16_b64_v4i16((LAS v4i16_t*)p)); }
typedef __amdgpu_buffer_rsrc_t rsrc_t;
__device__ __forceinline__ rsrc_t make_rsrc(const void* p) { return __builtin_amdgcn_make_buffer_rsrc((void*)p, 0, 0x7fffffff, 0x00020000); }
__device__ __forceinline__ v4u bufld16(rsrc_t r, unsigned voff, unsigned soff) { return __builtin_bit_cast(v4u, __builtin_amdgcn_raw_buffer_load_b128(r, (int)voff, (int)soff, 0)); }
__device__ __forceinline__ void bufst16(rsrc_t r, unsigned voff, unsigned soff, v4u v) { __builtin_amdgcn_raw_buffer_store_b128(v, r, (int)voff, (int)soff, 0); }
#define XB_TMO      128
#define XB_XCNT(j)  (256  + 64 * (j))
#define XB_XSUB(j)  (1280 + 64 * (j))
#define XB_XGEN(j)  (2304 + 64 * (j))
#define XB_TOP      3328
#define XB_TOPGEN   3392
#define XCD_BAR_WORDS 3456
#define XB_SPIN_CAP (1u << 18)

__device__ __forceinline__ unsigned xb_ld(unsigned* p)              { return __hip_atomic_load(p, __ATOMIC_RELAXED, __HIP_MEMORY_SCOPE_AGENT); }
__device__ __forceinline__ unsigned xb_add(unsigned* p, unsigned v) { return __hip_atomic_fetch_add(p, v, __ATOMIC_RELAXED, __HIP_MEMORY_SCOPE_AGENT); }
__device__ __forceinline__ unsigned xb_xcc_id() { return (unsigned)__builtin_amdgcn_s_getreg((3 << 11) | 20) & 0xFu; }
#define XB_SPIN(cond, bar) do { unsigned _sp = 0; while (cond) { __builtin_amdgcn_s_sleep(1); \
    if ((++_sp & 255u) == 0u) { if (xb_ld(&(bar)[XB_TMO])) break; if (_sp > XB_SPIN_CAP) { atomicAdd(&(bar)[XB_TMO], 1u); break; } } } } while (0)

struct XcdBarrier {
    unsigned* bar; unsigned x;
    volatile LAS unsigned* st;
};

__device__ __forceinline__ XcdBarrier xcd_barrier_post(unsigned* bar, volatile LAS unsigned* st) {
    XcdBarrier b; b.bar = bar; b.x = xb_xcc_id(); b.st = st;
    if (threadIdx.x == 0) (void)xb_add(&bar[XB_XCNT(b.x)], 1u);
    return b;
}
__device__ __forceinline__ void xcd_barrier_complete(unsigned* bar, unsigned x, unsigned& nloc, unsigned& nx) {
    const unsigned G = gridDim.x * gridDim.y * gridDim.z;
    unsigned sum, cnt, mine, sp = 0u;
    for (;;) {
        sum = 0u; cnt = 0u; mine = 0u;
#pragma unroll
        for (unsigned j = 0; j < 16; ++j) { const unsigned c = xb_ld(&bar[XB_XCNT(j)]); sum += c; cnt += (c > 0u) ? 1u : 0u; mine = (j == x) ? c : mine; }
        if (sum == G) break;
        __builtin_amdgcn_s_sleep(1);
        if ((++sp & 255u) == 0u) { if (xb_ld(&bar[XB_TMO])) break; if (sp > XB_SPIN_CAP) { atomicAdd(&bar[XB_TMO], 1u); break; } }
    }
    nloc = mine > 0u ? mine : 1u; nx = cnt > 0u ? cnt : 1u;
}

__device__ __forceinline__ void xcd_barrier(const XcdBarrier& b) {
    asm volatile("s_waitcnt vmcnt(0)" ::: "memory");
    __syncthreads();
    if (threadIdx.x == 0) {
        unsigned* bar = b.bar;
        __builtin_amdgcn_s_waitcnt(0);
        unsigned nloc = b.st[0], nx = b.st[1];
        if (nloc == 0u) { xcd_barrier_complete(bar, b.x, nloc, nx); b.st[0] = nloc; b.st[1] = nx; }
        const unsigned old = xb_add(&bar[XB_XSUB(b.x)], 1u);
        const unsigned gen = old / nloc;
        if (old + 1u == (gen + 1u) * nloc) {
            __builtin_amdgcn_fence(__ATOMIC_RELEASE, "agent");
            asm volatile("s_waitcnt vmcnt(0)" ::: "memory");
            const unsigned og = xb_add(&bar[XB_TOP], 1u);
            const unsigned tg = og / nx;
            if (og + 1u == (tg + 1u) * nx) xb_add(&bar[XB_TOPGEN], 1u);
            else XB_SPIN(xb_ld(&bar[XB_TOPGEN]) == tg, bar);
            __builtin_amdgcn_fence(__ATOMIC_ACQUIRE, "agent");
            xb_add(&bar[XB_XGEN(b.x)], 1u);
            asm volatile("s_waitcnt vmcnt(0)" ::: "memory");
        } else {
            XB_SPIN(xb_ld(&bar[XB_XGEN(b.x)]) == gen, bar);
            __builtin_amdgcn_fence(__ATOMIC_ACQUIRE, "agent");
            asm volatile("s_waitcnt vmcnt(0)" ::: "memory");
        }
    }
    __syncthreads();
}

struct Frame {
    LAS unsigned char* lds;
    int tid, lane, wave, G, vcu;
};
__device__ __forceinline__ float wave_sum(float v) {
#pragma unroll
    for (int o = 1; o < 64; o <<= 1) v += __shfl_xor(v, o);
    return v;
}
__device__ __forceinline__ unsigned f2bf(float f) { unsigned u = __builtin_bit_cast(unsigned, f); return (u + 0x7fffu + ((u >> 16) & 1u)) >> 16; }
__device__ __forceinline__ unsigned pk2(float lo, float hi) { return cvtpk(lo, hi); }

__device__ __forceinline__ void xpose_load(const float* W, int ldw, int src_col0, int k0, int lane, f32x4 (&v)[8]) {
    const int kc = lane & 7, ng = lane >> 3;
    if (src_col0 < 0) {
#pragma unroll
        for (int e = 0; e < 8; ++e) v[e] = (f32x4){0.f, 0.f, 0.f, 0.f};
        return; }
    const float* p = W + (size_t)(k0 + 8 * kc) * ldw + src_col0 + 4 * ng;
#pragma unroll
    for (int e = 0; e < 8; ++e) v[e] = __builtin_nontemporal_load((const GAS f32x4*)(p + (size_t)e * ldw));
}
__device__ __forceinline__ void xpose_store(const f32x4 (&v)[8], const float* gain, bf16* WT, int K, int dst_row0, int k0, int lane) {
    const int kc = lane & 7, ng = lane >> 3;
    f32x4 g0 = {1.f, 1.f, 1.f, 1.f}, g1 = g0;
    if (gain) { g0 = *(const GAS f32x4*)(gain + k0 + 8 * kc); g1 = *(const GAS f32x4*)(gain + k0 + 8 * kc + 4); }
    bf16* o = WT + (size_t)(dst_row0 + 4 * ng) * K + k0 + 8 * kc;
#pragma unroll
    for (int i = 0; i < 4; ++i) { v4u w; w.x = pk2(v[0][i] * g0[0], v[1][i] * g0[1]); w.y = pk2(v[2][i] * g0[2], v[3][i] * g0[3]); w.z = pk2(v[4][i] * g1[0], v[5][i] * g1[1]); w.w = pk2(v[6][i] * g1[2], v[7][i] * g1[3]);
        *(GAS v4u*)(o + (size_t)i * K) = w; }
}
__device__ __forceinline__ void xpose_store_g(const f32x4 (&v)[8], const f32x4 g0, const f32x4 g1, bf16* WT, int K, int dst_row0, int k0, int lane) {
    const int kc = lane & 7, ng = lane >> 3;
    bf16* o = WT + (size_t)(dst_row0 + 4 * ng) * K + k0 + 8 * kc;
#pragma unroll
    for (int i = 0; i < 4; ++i) { v4u w; w.x = pk2(v[0][i] * g0[0], v[1][i] * g0[1]); w.y = pk2(v[2][i] * g0[2], v[3][i] * g0[3]); w.z = pk2(v[4][i] * g1[0], v[5][i] * g1[1]); w.w = pk2(v[6][i] * g1[2], v[7][i] * g1[3]);
        *(GAS v4u*)(o + (size_t)i * K) = w; }
}
__device__ __forceinline__ void xpose_store8(const f32x4 (&v)[8], const float* gain, float scale, unsigned char* WT, int K, int dst_row0, int k0, int lane) {
    const int kc = lane & 7, ng = lane >> 3;
    f32x4 g0 = {scale, scale, scale, scale}, g1 = g0;
    if (gain) { g0 = *(const GAS f32x4*)(gain + k0 + 8 * kc) * scale; g1 = *(const GAS f32x4*)(gain + k0 + 8 * kc + 4) * scale; }
    unsigned char* o = WT + (size_t)(dst_row0 + 4 * ng) * K + k0 + 8 * kc;
#pragma unroll
    for (int i = 0; i < 4; ++i) { *(GAS v2u*)(o + (size_t)i * K) = pg8::pack8_fp8((f32x4){v[0][i] * g0[0], v[1][i] * g0[1], v[2][i] * g0[2], v[3][i] * g0[3]}, (f32x4){v[4][i] * g1[0], v[5][i] * g1[1], v[6][i] * g1[2], v[7][i] * g1[3]}); }
}
__device__ __forceinline__ void xpose_item2(const float* Wa, int srca, const float* Wb, int srcb, int ldw, const float* gain, bf16* WT, int K, int dst_row0, int k0, int lane) {
    f32x4 va[8], vb[8];
    xpose_load(Wa, ldw, srca, k0, lane, va); xpose_load(Wb, ldw, srcb, k0, lane, vb);
    xpose_store(va, gain, WT, K, dst_row0, k0, lane); xpose_store(vb, gain, WT, K, dst_row0 + 32, k0, lane);
}
__device__ __forceinline__ void sincos_acc(float ang, float& sn, float& cs) {
    const double a = (double)ang; const double kq = __builtin_rint(a * 0.6366197723675814); const double r = __builtin_fma(-kq, 1.5707963267948966, a) - kq * 6.123233995736766e-17;
    const double r2 = r * r;
    double sp = 1.6059043836821613e-10; sp = sp * r2 - 2.505210838544172e-08; sp = sp * r2 + 2.7557319223985893e-06; sp = sp * r2 - 0.0001984126984126984; sp = sp * r2 + 0.008333333333333333; sp = sp * r2 - 0.16666666666666666; sp = sp * r2 * r + r;
    double cp = 2.08767569878681e-09; cp = cp * r2 - 2.755731922398589e-07; cp = cp * r2 + 2.48015873015873e-05; cp = cp * r2 - 0.001388888888888889; cp = cp * r2 + 0.041666666666666664; cp = cp * r2 - 0.5; cp = cp * r2 + 1.0;
    const int q = (int)kq & 3;
    const double s = (q == 0) ? sp : (q == 1) ? cp : (q == 2) ? -sp : -cp;
    const double c = (q == 0) ? cp : (q == 1) ? -sp : (q == 2) ? -cp : sp;
    sn = (float)s; cs = (float)c;
}

struct In { const float *x, *p, *w_in, *g_attn, *g_q, *g_kv, *w_uq, *w_ukv, *w_o, *g_ffn, *w_gate, *w_up, *conv_w, *conv_b, *w_down, *g_ple, *w_pg, *w_pp, *g_final; };
struct Args { In in; float* out; unsigned char* ws; int ph_lo, ph_hi; };

__device__ __forceinline__ double ipow_d(double c, int j, int nbits) { double inv = 1.0, p = c; for (int b = 0; b < nbits; ++b) { if ((j >> b) & 1) inv *= p; p *= p; } return inv; }

__device__ __forceinline__ void p0_prologue(Frame& F, const In& I, unsigned char* ws) {
    const int gw = F.vcu * NWAVES + F.wave, NGW = F.G * NWAVES, lane = F.lane;
    bf16* Win_t = (bf16*)(ws + WS_WIN); unsigned char* Win8_t = ws + WS_WIN8; unsigned char* Wuq8_t = ws + WS_WUQ; unsigned char* Wukv8_t = ws + WS_WUKV;
    constexpr int I_IN = 128 * 64, I_IN8 = 28 * 64, I_UQ = 48 * 16, I_UKV = 64 * 8, I_PP = 64 * 4, NITEMS = I_IN + I_IN8 + I_UQ + I_UKV + I_PP;
    for (int it = gw; it < NITEMS; it += NGW) {
        int r = it;
        if (r < I_IN) { const int n0 = 64 * (r >> 6), k0 = 64 * (r & 63); xpose_item2(I.w_in, n0, I.w_in, n0 + 32, 9792, nullptr, Win_t, 4096, n0, k0, lane); continue; } r -= I_IN;
        if (r < I_IN8) { const int n0 = 64 * (r >> 6), k0 = 64 * (r & 63); int sa = 8192 + n0, sb = 8192 + n0 + 32;
            if (n0 >= 1536) { const int c = n0 - 1536; sa = (c == 0) ? 9728 : (c == 128 ? 9760 : -1); sb = -1; }
            f32x4 va[8], vb[8]; xpose_load(I.w_in, 9792, sa, k0, lane, va); xpose_load(I.w_in, 9792, sb, k0, lane, vb);
            xpose_store8(va, nullptr, pg8::W8_SCALE, Win8_t, 4096, n0, k0, lane); xpose_store8(vb, nullptr, pg8::W8_SCALE, Win8_t, 4096, n0 + 32, k0, lane); continue; } r -= I_IN8;
        if (r < I_UQ) { const int n0 = 64 * (r >> 4), k0 = 64 * (r & 15), pn = n0 >> 8; int sa, sb;
            { const int c = n0 & 255; if (pn < 8) sa = 192 * (2 * pn + (c >> 7)) + (c & 127); else sa = 192 * (4 * (pn - 8) + ((c & 127) >> 5)) + 128 + 32 * (c >> 7); }
            { const int c = (n0 + 32) & 255; if (pn < 8) sb = 192 * (2 * pn + (c >> 7)) + (c & 127); else sb = 192 * (4 * (pn - 8) + ((c & 127) >> 5)) + 128 + 32 * (c >> 7); }
            { f32x4 va[8], vb[8]; xpose_load(I.w_uq, 3072, sa, k0, lane, va); xpose_load(I.w_uq, 3072, sb, k0, lane, vb); xpose_store8(va, I.g_q, pg8::WQ8_SCALE, Wuq8_t, 1024, n0, k0, lane); xpose_store8(vb, I.g_q, pg8::WQ8_SCALE, Wuq8_t, 1024, n0 + 32, k0, lane); } continue; } r -= I_UQ;
        if (r >= I_UKV) { r -= I_UKV; const int n0 = 64 * (r >> 2), k0 = 64 * (r & 3); xpose_item2(I.w_pp, n0, I.w_pp, n0 + 32, 4096, nullptr, (bf16*)(ws + WS_WPP), 256, n0, k0, lane); continue; }
        { const int n0 = 64 * (r >> 3), k0 = 64 * (r & 7); f32x4 va[8], vb[8]; xpose_load(I.w_ukv, 4096, n0, k0, lane, va); xpose_load(I.w_ukv, 4096, n0 + 32, k0, lane, vb); xpose_store8(va, I.g_kv, pg8::WQ8_SCALE, Wukv8_t, 512, n0, k0, lane); xpose_store8(vb, I.g_kv, pg8::WQ8_SCALE, Wukv8_t, 512, n0 + 32, k0, lane); }
    }
    bf16* XB = (bf16*)(ws + WS_XB);
    for (int m = gw; m < M; m += NGW) {
        const GAS f32x4* xr = (const GAS f32x4*)(I.x + (size_t)m * DM) + lane; const GAS f32x4* gr = (const GAS f32x4*)I.g_attn + lane;
        f32x4 v[16]; float s = 0.f;
#pragma unroll
        for (int j = 0; j < 16; ++j) { v[j] = __builtin_nontemporal_load(xr + 64 * j); s += (v[j].x * v[j].x + v[j].y * v[j].y) + (v[j].z * v[j].z + v[j].w * v[j].w); }
        const float rstd = 1.0f / sqrtf(wave_sum(s) * (1.0f / DM) + 1e-6f);
        GAS v2u* o8 = (GAS v2u*)(XB + (size_t)m * DM) + lane; GAS unsigned* o1 = (GAS unsigned*)(ws + WS_XB8 + (size_t)m * DM) + lane;
#pragma unroll
        for (int j = 0; j < 16; ++j) { const f32x4 g = gr[64 * j]; const float y0 = v[j].x * rstd * g.x, y1 = v[j].y * rstd * g.y, y2 = v[j].z * rstd * g.z, y3 = v[j].w * rstd * g.w;
            v2u o; o.x = pk2(y0, y1); o.y = pk2(y2, y3); o8[64 * j] = o;
            int w8 = __builtin_amdgcn_cvt_pk_fp8_f32(y0, y1, 0, false); w8 = __builtin_amdgcn_cvt_pk_fp8_f32(y2, y3, w8, true); o1[64 * j] = (unsigned)w8; }
    }
    { bf16* PB = (bf16*)(ws + WS_PB);
      for (int i = gw * 64 + lane; i < M * 256 / 8; i += NGW * 64) { const f32x4 a = *(const GAS f32x4*)(I.p + (size_t)i * 8), b = *(const GAS f32x4*)(I.p + (size_t)i * 8 + 4);
          v4u o; o.x = pk2(a.x, a.y); o.y = pk2(a.z, a.w); o.z = pk2(b.x, b.y); o.w = pk2(b.z, b.w); *(GAS v4u*)(PB + (size_t)i * 8) = o; } }
    { float* cosR = (float*)(ws + WS_COSR); float* sinR = (float*)(ws + WS_SINR); float* cosM = (float*)(ws + WS_COSM); float* sinM = (float*)(ws + WS_SINM);
      for (int i = gw * 64 + lane; i < SEQ * 160; i += NGW * 64) {
          if (i < SEQ * 128) { const int pos = i >> 7, j = i & 127; const float inv = (float)ipow_d(0.930572040929699, j, 7); float sn, cs; sincos_acc((float)pos * inv, sn, cs); cosR[i] = cs; sinR[i] = sn; }
          else { const int k = i - SEQ * 128, pos = k >> 5, j = k & 31; const float inv = (float)ipow_d(0.7498942093324559, j, 5); float sn, cs; sincos_acc((float)pos * inv, sn, cs); cosM[k] = cs; sinM[k] = sn; } } }
}

constexpr int CV_O = 128 * 64, CV_GU = 688 * 64, CV_N = CV_O + CV_GU;
constexpr int CV_PRE = CV_O;
__device__ __forceinline__ void cv_load(const In& I, int it, int lane, f32x4 (&v)[8]) {
    if (it < CV_O) { xpose_load(I.w_o, 4096, 32 * (it >> 6), 64 * (it & 63), lane, v); return; }
    const int r = it - CV_O, n0 = 32 * (r >> 6), k0 = 64 * (r & 63), pn = n0 >> 8, cc = n0 & 255, src = 128 * pn + (cc & 127);
    if (cc < 128) xpose_load(I.w_gate, NFF, src, k0, lane, v); else xpose_load(I.w_up, NFF, src, k0, lane, v);
}
__device__ __forceinline__ void cv_store(const In& I, unsigned char* ws, int it, int lane, const f32x4 (&v)[8]) {
    if (it < CV_O) { const int n0 = 32 * (it >> 6), k0 = 64 * (it & 63);
        if (k0 < 2048) xpose_store(v, nullptr, (bf16*)(ws + WS_WO), CCP, n0, k0, lane); else xpose_store8(v, nullptr, pg8::W8_SCALE, ws + WS_WO + 4096, 2 * CCP, n0, k0 - 2048, lane); return; }
    const int r = it - CV_O; xpose_store(v, I.g_ffn, (bf16*)(ws + WS_WGU), 4096, 32 * (r >> 6), 64 * (r & 63), lane);
}
__device__ __forceinline__ void cvg_load(const In& I, int it, int lane, f32x4 (&v)[8]) {
    const int r = it - CV_O, n0 = 32 * (r >> 6), k0 = 64 * (r & 63), pn = n0 >> 8, cc = n0 & 255, src = 128 * pn + (cc & 127);
    if (cc < 128) xpose_load(I.w_gate, NFF, src, k0, lane, v); else xpose_load(I.w_up, NFF, src, k0, lane, v);
}
__device__ __forceinline__ void cvg_store(const In& I, unsigned char* ws, int it, int lane, const f32x4 (&v)[8]) {
    const int r = it - CV_O; xpose_store(v, I.g_ffn, (bf16*)(ws + WS_WGU), 4096, 32 * (r >> 6), 64 * (r & 63), lane);
}
__device__ __forceinline__ void pre_convert(Frame& F, const In& I, unsigned char* ws, int rank, int nranks, int n_items) {
    const int gw = rank * NWAVES + F.wave, NGW = nranks * NWAVES, lane = F.lane;
    for (int it = gw; it < n_items; it += 2 * NGW) { f32x4 va[8], vb[8]; const int it2 = it + NGW;
        cv_load(I, it, lane, va); if (it2 < n_items) cv_load(I, it2, lane, vb);
        cv_store(I, ws, it, lane, va); if (it2 < n_items) cv_store(I, ws, it2, lane, vb); }
}
namespace ret {
constexpr int LQ = 0, LK = 32768, LV = 65536, LV2 = 69632, LS = 73728, LRED = 106496;
__device__ __forceinline__ int off_k(int row, int ch) { return 4096 * (row >> 3) + 512 * (ch >> 2) + 64 * (row & 7) + 16 * ((ch & 3) ^ ((row >> 2) & 3)); }
__device__ __forceinline__ int off_v(int row, int ch) { return 512 * (row >> 3) + 64 * (row & 7) + 16 * (ch ^ ((row >> 2) & 3)); }
}
__device__ __forceinline__ void retention_phase(Frame& F, const In& I, unsigned char* ws, int cv_base) {
    using namespace ret;
    LAS unsigned char* lds = F.lds;
    const int tid = F.tid, lane = F.lane, wid = F.wave, r32 = lane & 31, hi = lane >> 5;
    const bf16* PJ = (const bf16*)(ws + WS_PROJ); bf16* CC = (bf16*)(ws + WS_XB); float* ST = (float*)(ws + WS_STATS);
    const int rowpart = 4096 * (r32 >> 3) + 64 * (r32 & 7), xr = (r32 >> 2) & 3;
    const int baseE = rowpart + 16 * (hi ^ xr), baseO = rowpart + 16 * ((2 + hi) ^ xr);
    const int tq = (lane & 15) >> 2, tp = lane & 3, tblk = (lane >> 4) & 1;
    const int trk0 = 4096 * hi + 64 * tq + 16 * ((2 * tblk + (tp >> 1)) ^ (2 * hi)) + 8 * (tp & 1);
    const int trk1 = 4096 * hi + 64 * (4 + tq) + 16 * ((2 * tblk + (tp >> 1)) ^ (2 * hi + 1)) + 8 * (tp & 1);
    const int trv0 = 512 * hi + 64 * tq + 16 * ((2 * tblk + (tp >> 1)) ^ (2 * hi)) + 8 * (tp & 1);
    const int trv1 = 512 * hi + 64 * (4 + tq) + 16 * ((2 * tblk + (tp >> 1)) ^ (2 * hi + 1)) + 8 * (tp & 1);
    for (int unit = blockIdx.x; unit < 256; unit += F.G) {
        const int bh = (unit & 7) + 8 * ((unit >> 3) & 3), sl = unit >> 5, b = bh >> 3, h = bh & 7;
        float lg; { const double e = 1.0 / (double)(32 << h); double t = e, acc = 0.0; for (int k = 1; k <= 10; ++k) { acc += t / (double)k; t *= e; } lg = (float)(-acc * 1.4426950408889634); }
        const float a64 = exp2f(lg * 64.0f);
        const size_t rowbase = (size_t)b * SEQ;
        const bool intra = (wid < 2), inter = (wid == 2 || wid == 3 || wid == 6 || wid == 7);
        const int qb = wid & 1, dkh = (wid >> 2) & 1;
        LAS float* gt = (LAS float*)(lds + 132096);
        if (tid < 128) gt[tid] = exp2f(lg * fabsf((float)(tid - 63)));
        const int nq = 32 * qb + r32;
        const LAS float* gtq = gt + (nq - 4 * hi + 4); const LAS float* gti = gt + (64 + 32 * qb + 4 * hi);
        f32x16 S = {};
        const int vrow = (tid >> 2) & 63, vch = tid & 3; const float kd = exp2f(lg * (float)(63 - vrow));
        v4u sq[4], sk[4], sv;
        const unsigned qoff = (unsigned)(((tid >> 5) * LDP + 8 * (tid & 31)) * 2), voffg = (unsigned)((vrow * LDP + 4096 + 32 * sl + 8 * vch) * 2);
#define RET_LOAD(c) do { const char* base_ = (const char*)(PJ + (rowbase + (size_t)(c) * 64) * LDP + h * 256); \
        _Pragma("unroll") for (int i_ = 0; i_ < 4; ++i_) { const char* rb_ = base_ + (size_t)i_ * 16 * LDP * 2; sq[i_] = *(const GAS v4u*)(rb_ + qoff); sk[i_] = *(const GAS v4u*)(rb_ + 4096 + qoff); } \
        sv = *(const GAS v4u*)(base_ + voffg); } while (0)
#define RET_WRITE() do { _Pragma("unroll") for (int i_ = 0; i_ < 4; ++i_) { const int id_ = tid + 512 * i_; const int o_ = off_k(id_ >> 5, id_ & 31); *(LAS v4u*)(lds + LQ + o_) = sq[i_]; *(LAS v4u*)(lds + LK + o_) = sk[i_]; } \
        if (tid < 256) { const int o_ = off_v(vrow, vch); *(LAS v4u*)(lds + LV + o_) = sv; v4u w_; \
            w_.x = cvtpk(bflo(sv.x) * kd, bfhi(sv.x) * kd); w_.y = cvtpk(bflo(sv.y) * kd, bfhi(sv.y) * kd); w_.z = cvtpk(bflo(sv.z) * kd, bfhi(sv.z) * kd); w_.w = cvtpk(bflo(sv.w) * kd, bfhi(sv.w) * kd); \
            *(LAS v4u*)(lds + LV2 + o_) = w_; } } while (0)
        f32x4 cva[8]; int cv_prev = -1, cg_k0 = -1; LAS float* cgl = (LAS float*)(lds + 132608) + wid * 64;
        const int cv_slot = (unit - (int)blockIdx.x) / F.G * 384 + (wid - 2);
        RET_LOAD(0);
        for (int i = tid; i < 1024; i += 512) *(LAS v4u*)(lds + LS + 16 * i) = (v4u){0u, 0u, 0u, 0u};
        VM_WAIT(); RET_WRITE(); LDS_WAIT(); __builtin_amdgcn_s_barrier(); asm volatile("" ::: "memory");
        for (int c = 0; c < 64; ++c) {
            const int cur = c & 1;

            const bool cvt = wid >= 2;
            if (cvt && cv_prev >= 0) { const int k0p = 64 * ((cv_prev - CV_O) & 63);
                if (k0p != cg_k0) { cgl[lane] = I.g_ffn[k0p + lane]; cg_k0 = k0p; } }
            if (c + 1 < 64) RET_LOAD(c + 1);
            if (cvt) {
                if (cv_prev >= 0) { const int r_ = cv_prev - CV_O; const f32x4 cg0 = *(const LAS f32x4*)(cgl + 8 * (lane & 7)), cg1 = *(const LAS f32x4*)(cgl + 8 * (lane & 7) + 4);
                    xpose_store_g(cva, cg0, cg1, (bf16*)(ws + WS_WGU), 4096, 32 * (r_ >> 6), 64 * (r_ & 63), lane); }
                const int it = cv_base + (cv_slot + 6 * c) * F.G + (int)blockIdx.x;
                if (it < CV_N) { cvg_load(I, it, lane, cva); cv_prev = it; } else cv_prev = -1;
            }
#define SGB(mask_, n_) __builtin_amdgcn_sched_group_barrier(mask_, n_, 0)
#define OPAQUE16(G) asm volatile("" : "+v"(G[0]), "+v"(G[1]), "+v"(G[2]), "+v"(G[3]), "+v"(G[4]), "+v"(G[5]), "+v"(G[6]), "+v"(G[7]), "+v"(G[8]), "+v"(G[9]), "+v"(G[10]), "+v"(G[11]), "+v"(G[12]), "+v"(G[13]), "+v"(G[14]), "+v"(G[15]))
#ifndef RET_PIPE_QK
#define RET_PIPE_QK 1
#endif
#ifndef RET_PIPE_QS
#define RET_PIPE_QS 1
#endif
            if (intra) {
                f32x16 p0 = {}, p1 = {};
                bf16x8 fa0[2][2], fa1[2][2], fbq[2][2];
#define QK_LOAD(g_, sl_) do { _Pragma("unroll") for (int e_ = 0; e_ < 2; ++e_) { const int d0_ = 2 * (g_) + e_; const int o_ = ((d0_ & 1) ? baseO : baseE) + 512 * (d0_ >> 1); \
        fa0[sl_][e_] = *(const LAS bf16x8*)(lds + LK + o_); fa1[sl_][e_] = *(const LAS bf16x8*)(lds + LK + 16384 + o_); fbq[sl_][e_] = *(const LAS bf16x8*)(lds + LQ + 16384 * qb + o_); } } while (0)
                QK_LOAD(0, 0); SBAR();
#pragma unroll
                for (int g = 0; g < 8; ++g) {
                    if (g + 1 < 8) { QK_LOAD(g + 1, (g + 1) & 1); SBAR(); }
#pragma unroll
                    for (int e = 0; e < 2; ++e) { p0 = __builtin_amdgcn_mfma_f32_32x32x16_bf16(fa0[g & 1][e], fbq[g & 1][e], p0, 0, 0, 0); p1 = __builtin_amdgcn_mfma_f32_32x32x16_bf16(fa1[g & 1][e], fbq[g & 1][e], p1, 0, 0, 0); }
                    SBAR(); }
#undef QK_LOAD
#define VFRAG(img, ks) ({ const s16x4 l_ = tr_read(lds + (img) + trv0 + 1024 * (ks)), h_ = tr_read(lds + (img) + trv1 + 1024 * (ks)); (bf16x8){l_[0], l_[1], l_[2], l_[3], h_[0], h_[1], h_[2], h_[3]}; })
#define PK4(P, B_, OUT) do { unsigned a0_ = cvtpk(P[B_ + 0], P[B_ + 1]), a1_ = cvtpk(P[B_ + 2], P[B_ + 3]); unsigned b0_ = cvtpk(P[B_ + 4], P[B_ + 5]), b1_ = cvtpk(P[B_ + 6], P[B_ + 7]); \
        auto r0_ = __builtin_amdgcn_permlane32_swap(a0_, b0_, false, false); auto r1_ = __builtin_amdgcn_permlane32_swap(a1_, b1_, false, false); \
        v4u w_ = {r0_[0], r1_[0], r0_[1], r1_[1]}; OUT = __builtin_bit_cast(bf16x8, w_); } while (0)
                bf16x8 vf[4], pa0, pa1, pa2, pa3;
                { float g[16];
#pragma unroll
                  for (int r = 0; r < 16; ++r) g[r] = gtq[59 - ((r & 3) + 8 * (r >> 2))];
                  asm volatile("" ::: "memory"); SBAR(); OPAQUE16(g);
#pragma unroll
                  for (int r = 0; r < 16; ++r) p0[r] *= g[r]; }
                { float g[16];
#pragma unroll
                  for (int r = 0; r < 16; ++r) g[r] = gtq[27 - ((r & 3) + 8 * (r >> 2))];
#pragma unroll
                  for (int ks = 0; ks < 4; ++ks) vf[ks] = VFRAG(LV, ks);
                  asm volatile("" ::: "memory"); SBAR();
                  PK4(p0, 0, pa0); PK4(p0, 8, pa1);
                  SBAR(); OPAQUE16(g);
#pragma unroll
                  for (int r = 0; r < 16; ++r) p1[r] *= g[r]; }
                PK4(p1, 0, pa2); PK4(p1, 8, pa3);
                f32x16 o = {};
                o = __builtin_amdgcn_mfma_f32_32x32x16_bf16(pa0, vf[0], o, 0, 0, 0); o = __builtin_amdgcn_mfma_f32_32x32x16_bf16(pa1, vf[1], o, 0, 0, 0);
                o = __builtin_amdgcn_mfma_f32_32x32x16_bf16(pa2, vf[2], o, 0, 0, 0); o = __builtin_amdgcn_mfma_f32_32x32x16_bf16(pa3, vf[3], o, 0, 0, 0);
                LAS float* red = (LAS float*)(lds + LRED) + (qb * 3 + 0) * 1024;
#pragma unroll
                for (int r = 0; r < 16; ++r) red[crow(r, hi) * 32 + r32] = o[r];
            } else if (inter) {
                float gi[16];
#pragma unroll
                for (int r = 0; r < 16; ++r) gi[r] = gti[(r & 3) + 8 * (r >> 2)];
                SBAR();
                f32x16 o = {};
                bf16x8 fq[2][2], fs[2][2];
#define QS_LOAD(g_, sl_) do { _Pragma("unroll") for (int e_ = 0; e_ < 2; ++e_) { const int d0_ = 8 * dkh + 2 * (g_) + e_; const int o_ = ((d0_ & 1) ? baseO : baseE) + 512 * (d0_ >> 1); \
        fq[sl_][e_] = *(const LAS bf16x8*)(lds + LQ + 16384 * qb + o_); fs[sl_][e_] = *(const LAS bf16x8*)(lds + LS + 16384 * cur + o_); } } while (0)
                QS_LOAD(0, 0); SBAR();
#pragma unroll
                for (int g = 0; g < 4; ++g) {
                    if (g + 1 < 4) { QS_LOAD(g + 1, (g + 1) & 1); SBAR(); }
#pragma unroll
                    for (int e = 0; e < 2; ++e) o = __builtin_amdgcn_mfma_f32_32x32x16_bf16(fq[g & 1][e], fs[g & 1][e], o, 0, 0, 0);
                    SBAR(); }
#undef QS_LOAD
                LAS float* red = (LAS float*)(lds + LRED) + (qb * 3 + 1 + dkh) * 1024;
#pragma unroll
                for (int r = 0; r < 16; ++r) red[crow(r, hi) * 32 + r32] = o[r] * gi[r];
            }
            { bf16x8 ak[4], vk[4];
#pragma unroll
              for (int ks = 0; ks < 4; ++ks) { const s16x4 l_ = tr_read(lds + LK + trk0 + 8192 * ks + 512 * wid), h_ = tr_read(lds + LK + trk1 + 8192 * ks + 512 * wid);
                  ak[ks] = (bf16x8){l_[0], l_[1], l_[2], l_[3], h_[0], h_[1], h_[2], h_[3]}; vk[ks] = VFRAG(LV2, ks); }
              SBAR();
#pragma unroll
              for (int r = 0; r < 16; ++r) S[r] *= a64;
#pragma unroll
              for (int ks = 0; ks < 4; ++ks) S = __builtin_amdgcn_mfma_f32_32x32x16_bf16(ak[ks], vk[ks], S, 0, 0, 0); }
#pragma unroll
            for (int g = 0; g < 4; ++g) { v2u w_; w_.x = cvtpk(S[4 * g], S[4 * g + 1]); w_.y = cvtpk(S[4 * g + 2], S[4 * g + 3]);
                *(LAS v2u*)(lds + LS + 16384 * (cur ^ 1) + off_k(r32, 4 * wid + g) + 8 * hi) = w_; }
            LDS_WAIT(); __builtin_amdgcn_s_barrier(); asm volatile("" ::: "memory");
            { const int n = tid >> 3, cg = tid & 7, qb2 = n >> 5, row = n & 31;
              const LAS float* rp = (const LAS float*)(lds + LRED) + (qb2 * 3) * 1024 + row * 32 + 4 * cg;
              const f32x4 v = *(const LAS f32x4*)rp + *(const LAS f32x4*)(rp + 1024) + *(const LAS f32x4*)(rp + 2048);
              float s1 = (v[0] + v[1]) + (v[2] + v[3]), s2 = (v[0] * v[0] + v[1] * v[1]) + (v[2] * v[2] + v[3] * v[3]);
              s1 += __shfl_xor(s1, 1); s2 += __shfl_xor(s2, 1); s1 += __shfl_xor(s1, 2); s2 += __shfl_xor(s2, 2); s1 += __shfl_xor(s1, 4); s2 += __shfl_xor(s2, 4);
              const size_t t = rowbase + (size_t)c * 64 + n;
              v2u w_; w_.x = cvtpk(v[0], v[1]); w_.y = cvtpk(v[2], v[3]);
              *(GAS v2u*)(CC + t * CCP + h * 256 + 32 * sl + 4 * cg) = w_;
              if (cg == 0) { float* sp = ST + ((t * 8 + h) * 8 + sl) * 2; sp[0] = s1; sp[1] = s2; } }
            if (c + 1 < 64) { RET_WRITE(); }
            LDS_WAIT(); __builtin_amdgcn_s_barrier(); asm volatile("" ::: "memory");
        }
        if (wid >= 2 && cv_prev >= 0) { const int r_ = cv_prev - CV_O, k0p = 64 * (r_ & 63);
            if (k0p != cg_k0) { cgl[lane] = I.g_ffn[k0p + lane]; cg_k0 = k0p; }
            const f32x4 cg0 = *(const LAS f32x4*)(cgl + 8 * (lane & 7)), cg1 = *(const LAS f32x4*)(cgl + 8 * (lane & 7) + 4);
            xpose_store_g(cva, cg0, cg1, (bf16*)(ws + WS_WGU), 4096, 32 * (r_ >> 6), k0p, lane); }
#undef RET_LOAD
#undef RET_WRITE
#undef PK4
#undef SGB
#undef OPAQUE16
#undef VFRAG
    }
}

__device__ __forceinline__ void ro_finalize(Frame& F, unsigned char* ws) {
    const int gw = F.vcu * NWAVES + F.wave, NGW = F.G * NWAVES, lane = F.lane;
    bf16* CC = (bf16*)(ws + WS_XB); const bf16* PJ = (const bf16*)(ws + WS_PROJ); const float* ST = (const float*)(ws + WS_STATS);
    for (int it0 = gw; it0 < M * 8; it0 += 4 * NGW) {
        f32x4 st[4][4]; v2u rv[4], gv[4];
#pragma unroll
        for (int k = 0; k < 4; ++k) { const int it = it0 + k * NGW; if (it < M * 8) { const size_t t = (size_t)(it >> 3); const int h = it & 7; const f32x4* sp = (const f32x4*)(ST + (size_t)it * 16);
            st[k][0] = sp[0]; st[k][1] = sp[1]; st[k][2] = sp[2]; st[k][3] = sp[3]; rv[k] = *(const GAS v2u*)(CC + t * CCP + h * 256 + 4 * lane); gv[k] = *(const GAS v2u*)(PJ + t * LDP + 6144 + h * 256 + 4 * lane); } }
#pragma unroll
        for (int k = 0; k < 4; ++k) { const int it = it0 + k * NGW; if (it < M * 8) { const size_t t = (size_t)(it >> 3); const int h = it & 7;
            const f32x4 a = st[k][0], b = st[k][1], c = st[k][2], d = st[k][3];
            const float s1 = ((a[0] + a[2]) + (b[0] + b[2])) + ((c[0] + c[2]) + (d[0] + d[2])), s2 = ((a[1] + a[3]) + (b[1] + b[3])) + ((c[1] + c[3]) + (d[1] + d[3]));
            const float mu = s1 * (1.0f / 256.0f), var = fmaxf(s2 * (1.0f / 256.0f) - mu * mu, 0.f), rstd = 1.0f / sqrtf(var + 1e-6f);
            float r[4] = {bflo(rv[k].x), bfhi(rv[k].x), bflo(rv[k].y), bfhi(rv[k].y)}, g[4] = {bflo(gv[k].x), bfhi(gv[k].x), bflo(gv[k].y), bfhi(gv[k].y)}, o[4];
#pragma unroll
            for (int i = 0; i < 4; ++i) { const float sg = g[i] / (1.0f + __expf(-g[i])); o[i] = (r[i] - mu) * rstd * sg; }
            v2u w; w.x = pk2(o[0], o[1]); w.y = pk2(o[2], o[3]); *(GAS v2u*)(CC + t * CCP + h * 256 + 4 * lane) = w; } }
    }
}

namespace att {
constexpr int TB = 20480, O_KR = 8192, O_V = 12288, LWS = 132096;
constexpr float SCALE = 0.07216878364870322f, C2 = 0.10411754627697264f, THR = 5.f;
typedef int v8i32 __attribute__((ext_vector_type(8)));
typedef int v4i32 __attribute__((ext_vector_type(4)));
}
template <int VAR> __device__ __forceinline__ void attn_unit(Frame& F, unsigned char* ws, int b, int h, int qblk) {
    using namespace att;
    LAS unsigned char* lds = F.lds;
    const int tid = F.tid, lane = F.lane, wid = F.wave, r32 = lane & 31, hi = lane >> 5;
    const unsigned rowbase = (unsigned)b * SEQ; const int q0 = 256 * qblk, NT = 4 * qblk + 4, my_last = 4 * qblk + (wid >> 1);
    LAS float* wsf = (LAS float*)(lds + LWS) + wid * 64;
    const rsrc_t rs = make_rsrc(ws);
    const v4i32 rs4 = { (int)(unsigned)(unsigned long long)ws, (int)((unsigned)((unsigned long long)ws >> 32) & 0xffffu), 0x7fffffff, 0x00020000 };
    const unsigned vbase_g = (unsigned)WS_VB + (unsigned)((b * 16 + h) * 128) * 4096u;
    const int rn = 8 * wid + (lane >> 3), rr = 16 * wid + (lane >> 2);
    const unsigned vn = (unsigned)(rn * 2048 + 16 * ((lane & 7) ^ ((rn >> 1) & 7)));
    const unsigned vr = (unsigned)(rr * 64 + 16 * ((lane & 3) ^ ((rr >> 2) & 3)));
    const unsigned vv = (unsigned)(rr * 4096 + 16 * ((lane & 3) ^ ((rr >> 2) & 3)));
    const unsigned m0n = (unsigned)(size_t)lds + 1024u * wid, m0r = m0n + O_KR, m0v = m0n + O_V;
#define AT_DMA(m0_, voff_, soff_) asm volatile("s_mov_b32 m0, %0\n\ts_nop 0\n\tbuffer_load_dwordx4 %1, %2, %3 offen lds" :: "s"(m0_), "v"(voff_), "s"(rs4), "s"(soff_) : "m0", "memory")
#define AT_DMA_TILE(t_, boff_) do { const unsigned kr_ = rowbase + 64u * (unsigned)(t_); AT_DMA(m0n + (boff_), vn, (unsigned)WS_KB + kr_ * 2048u + 128u * h); \
        if (wid < 4) AT_DMA(m0r + (boff_), vr, (unsigned)WS_KR + kr_ * 64u); AT_DMA(m0v + (boff_), vv, vbase_g + 64u * (unsigned)(t_)); } while (0)
#define AT_DMA_WAIT(younger_) do { if (!(younger_)) asm volatile("s_waitcnt vmcnt(0)" ::: "memory"); else if (wid < 4) asm volatile("s_waitcnt vmcnt(3)" ::: "memory"); else asm volatile("s_waitcnt vmcnt(2)" ::: "memory"); } while (0)
    AT_DMA_TILE(0, 0); AT_DMA_TILE(1, TB);
    v8i32 qf[3];
    { const unsigned qv = (unsigned)(r32 * 3072 + 32 * hi), qs = (unsigned)WS_Q + (unsigned)((rowbase + q0 + 32 * wid) * 3072 + 192 * h);
#pragma unroll
      for (int s = 0; s < 3; ++s) { qf[s].lo = __builtin_bit_cast(v4i32, bufld16(rs, qv, qs + 64 * s)); qf[s].hi = __builtin_bit_cast(v4i32, bufld16(rs, qv, qs + 64 * s + 16)); } }
    __builtin_amdgcn_s_waitcnt(0x0F70);
    asm volatile("" : "+v"(qf[0]), "+v"(qf[1]), "+v"(qf[2]));
    const int xn = (r32 >> 1) & 7, xr = (r32 >> 2) & 3;
    const int kn00 = 128 * r32 + 16 * ((2 * hi) ^ xn), kn01 = 128 * r32 + 16 * ((2 * hi + 1) ^ xn), kn10 = 128 * r32 + 16 * ((4 + 2 * hi) ^ xn), kn11 = 128 * r32 + 16 * ((5 + 2 * hi) ^ xn);
    const int kr0 = O_KR + 64 * r32 + 16 * ((2 * hi) ^ xr), kr1 = O_KR + 64 * r32 + 16 * ((2 * hi + 1) ^ xr);
    const int vb0 = O_V + 64 * r32 + 16 * ((2 * hi) ^ xr), vb1 = O_V + 64 * r32 + 16 * ((2 * hi + 1) ^ xr);
    const int unit_scale = 0x7f7f7f7f;
    float m_reg = -1e30f, l_reg = 0.f; f32x16 o[4] = {};
    int bcur = 0, bn1 = TB, bn2 = 2 * TB;
    __builtin_amdgcn_s_barrier(); asm volatile("" ::: "memory");
    for (int t = 0; t < NT; ++t) {
        const bool active = (t <= my_last);
        if (t + 2 < NT) AT_DMA_TILE(t + 2, bn2);
        if (active) {
            f32x16 p0 = {}, p1 = {};
            const LAS unsigned char* kbase = lds + bcur;
            if (VAR != 3) { v8i32 k0, k1;
              k0.lo = *(const LAS v4i32*)(kbase + kn00); k0.hi = *(const LAS v4i32*)(kbase + kn01); k1.lo = *(const LAS v4i32*)(kbase + 4096 + kn00); k1.hi = *(const LAS v4i32*)(kbase + 4096 + kn01);
              p0 = __builtin_amdgcn_mfma_scale_f32_32x32x64_f8f6f4(k0, qf[0], p0, 0, 0, 0, unit_scale, 0, unit_scale); p1 = __builtin_amdgcn_mfma_scale_f32_32x32x64_f8f6f4(k1, qf[0], p1, 0, 0, 0, unit_scale, 0, unit_scale);
              k0.lo = *(const LAS v4i32*)(kbase + kn10); k0.hi = *(const LAS v4i32*)(kbase + kn11); k1.lo = *(const LAS v4i32*)(kbase + 4096 + kn10); k1.hi = *(const LAS v4i32*)(kbase + 4096 + kn11);
              p0 = __builtin_amdgcn_mfma_scale_f32_32x32x64_f8f6f4(k0, qf[1], p0, 0, 0, 0, unit_scale, 0, unit_scale); p1 = __builtin_amdgcn_mfma_scale_f32_32x32x64_f8f6f4(k1, qf[1], p1, 0, 0, 0, unit_scale, 0, unit_scale);
              k0.lo = *(const LAS v4i32*)(kbase + kr0); k0.hi = *(const LAS v4i32*)(kbase + kr1); k1.lo = *(const LAS v4i32*)(kbase + 2048 + kr0); k1.hi = *(const LAS v4i32*)(kbase + 2048 + kr1);
              p0 = __builtin_amdgcn_mfma_scale_f32_32x32x64_f8f6f4(k0, qf[2], p0, 0, 0, 0, unit_scale, 0, unit_scale); p1 = __builtin_amdgcn_mfma_scale_f32_32x32x64_f8f6f4(k1, qf[2], p1, 0, 0, 0, unit_scale, 0, unit_scale); }
            v8i32 vf[4];
#pragma unroll
            for (int c = 0; c < 4; ++c) { vf[c].lo = *(const LAS v4i32*)(kbase + vb0 + 2048 * c); vf[c].hi = *(const LAS v4i32*)(kbase + vb1 + 2048 * c); }
            asm volatile("" ::: "memory"); SBAR();
            if (VAR != 2) {
            float pmax = p0[0];
#pragma unroll
            for (int r = 1; r < 16; ++r) pmax = fmaxf(pmax, p0[r]);
#pragma unroll
            for (int r = 0; r < 16; ++r) pmax = fmaxf(pmax, p1[r]);
            { auto rr_ = __builtin_amdgcn_permlane32_swap(__float_as_uint(pmax), __float_as_uint(pmax), false, false); pmax = fmaxf(__uint_as_float(rr_[0]), __uint_as_float(rr_[1])); }
            float mn, alpha;
            if (__all((pmax - m_reg) * SCALE <= THR)) { mn = m_reg; alpha = 1.f; }
            else { mn = fmaxf(m_reg, pmax); alpha = __builtin_amdgcn_exp2f((m_reg - mn) * C2); m_reg = mn; }
            const float mnL = -mn * C2;
#pragma unroll
            for (int r = 0; r < 16; ++r) { p0[r] = __builtin_amdgcn_exp2f(fmaf(p0[r], C2, mnL)); p1[r] = __builtin_amdgcn_exp2f(fmaf(p1[r], C2, mnL)); }
            float ps = 0.f;
#pragma unroll
            for (int r = 0; r < 16; ++r) ps += p0[r] + p1[r];
            { auto rr_ = __builtin_amdgcn_permlane32_swap(__float_as_uint(ps), __float_as_uint(ps), false, false); ps = __uint_as_float(rr_[0]) + __uint_as_float(rr_[1]); }
            l_reg = l_reg * alpha + ps;
            if (__any(alpha < 1.f)) { if (hi == 0) wsf[r32] = alpha; LDS_WAIT();
#pragma unroll
                for (int r = 0; r < 16; ++r) { const float al = wsf[crow(r, hi)];
#pragma unroll
                    for (int c = 0; c < 4; ++c) o[c][r] *= al; } }
            }
            v8i32 P8;
#pragma unroll
            for (int d = 0; d < 4; ++d) { int w0 = __builtin_amdgcn_cvt_pk_fp8_f32(p0[4 * d], p0[4 * d + 1], 0, false); w0 = __builtin_amdgcn_cvt_pk_fp8_f32(p0[4 * d + 2], p0[4 * d + 3], w0, true); P8[d] = w0;
                int w1 = __builtin_amdgcn_cvt_pk_fp8_f32(p1[4 * d], p1[4 * d + 1], 0, false); w1 = __builtin_amdgcn_cvt_pk_fp8_f32(p1[4 * d + 2], p1[4 * d + 3], w1, true); P8[4 + d] = w1; }
#pragma unroll
            for (int c = 0; c < 4; ++c) { if (VAR != 3) o[c] = __builtin_amdgcn_mfma_scale_f32_32x32x64_f8f6f4(P8, vf[c], o[c], 0, 0, 0, unit_scale, 0, unit_scale); else { o[c][0] += __int_as_float(P8[c] ^ vf[c][0]); } }
        }
        if (t + 1 < NT) AT_DMA_WAIT(t + 2 < NT);
        LDS_WAIT(); if (VAR != 4) __builtin_amdgcn_s_barrier(); asm volatile("" ::: "memory");
        { const int b_ = bcur; bcur = bn1; bn1 = bn2; bn2 = b_; }
    }
    if (hi == 0) wsf[r32] = l_reg;
    { LAS float* og = (LAS float*)(lds + wid * 16384);
#pragma unroll
      for (int c = 0; c < 4; ++c)
#pragma unroll
          for (int r = 0; r < 16; ++r) og[crow(r, hi) * 128 + 32 * c + r32] = o[c][r];
      LDS_WAIT();
      const unsigned obase = (unsigned)(VAR ? WS_ACT : WS_XB) + (unsigned)((rowbase + q0 + 32 * wid) * (2 * CCP) + 4096 + 128 * h);
      const unsigned ooff = (unsigned)((lane >> 4) * (2 * CCP) + 8 * (lane & 15));
#pragma unroll
      for (int j = 0; j < 8; ++j) { const int row = (lane >> 4) + 4 * j; const float rl = MO8_SCALE * __builtin_amdgcn_rcpf(wsf[row]);
          const f32x4 a = *(const LAS f32x4*)(og + row * 128 + 8 * (lane & 15)), bq = *(const LAS f32x4*)(og + row * 128 + 8 * (lane & 15) + 4);
          const v2u w = __builtin_bit_cast(v2u, pg8::pack8_fp8(a * rl, bq * rl));
          __builtin_amdgcn_raw_buffer_store_b64(w, rs, (int)ooff, (int)(obase + (unsigned)(j * 4 * 2 * CCP)), 0); } }
    LDS_WAIT(); __builtin_amdgcn_s_barrier(); asm volatile("" ::: "memory");
#undef AT_DMA
#undef AT_DMA_TILE
#undef AT_DMA_WAIT
}
template <int VAR> __device__ __forceinline__ void attn_phase(Frame& F, unsigned char* ws) {
    const int G = F.G;
    for (int slot = (int)blockIdx.x; slot < 512; slot += G) {
        int it = slot;
        if ((G & 7) == 0) { const int x = slot & 7, idx = slot >> 3; it = ((x * 8 + (idx >> 3)) << 3) | (idx & 7); }
        const int bh = it >> 3, y = it & 7;
        for (int e = 0; e < 2; ++e) attn_unit<VAR>(F, ws, bh >> 4, bh & 15, e ? y : 15 - y);
    }
}

__device__ __forceinline__ void fixup_phase(Frame& F, const In& I, unsigned char* ws) {
    const int gw = F.vcu * NWAVES + F.wave, NGW = F.G * NWAVES, lane = F.lane;
    const float* GT = (const float*)(ws + WS_GT); const float* GH = (const float*)(ws + WS_GH); const float* UH = (const float*)(ws + WS_UH); bf16* ACT = (bf16*)(ws + WS_ACT);
    constexpr int NV = NFF / 4;
    for (int i = gw * 64 + lane; i < NGRP * 2 * NV; i += NGW * 64) {
        const int fv = i % NV, gj = i / NV, j = gj & 1, g = gj >> 1, f = 4 * fv; const bool first = (g & 63) == 0;
        const f32x4 z = {0.f, 0.f, 0.f, 0.f};
        const f32x4 G0 = *(const f32x4*)(GH + ((size_t)g * 2 + j) * NFF + f), U0 = *(const f32x4*)(UH + ((size_t)g * 2 + j) * NFF + f);
        const f32x4 T1 = first ? z : *(const f32x4*)(GT + ((size_t)(g - 1) * 2 + 1) * NFF + f), T0 = first ? z : *(const f32x4*)(GT + ((size_t)(g - 1) * 2 + 0) * NFF + f);
        const f32x4 G1 = j ? *(const f32x4*)(GH + ((size_t)g * 2) * NFF + f) : T1, G2 = j ? T1 : T0;
        const f32x4 w0 = *(const f32x4*)(I.conv_w + f), w1 = *(const f32x4*)(I.conv_w + NFF + f), w2 = *(const f32x4*)(I.conv_w + 2 * NFF + f), bb = *(const f32x4*)(I.conv_b + f);
        float o[4];
#pragma unroll
        for (int e = 0; e < 4; ++e) { const float a = bb[e] + w0[e] * G2[e] + w1[e] * G1[e] + w2[e] * G0[e]; o[e] = a / (1.0f + __expf(-a)) * U0[e]; }
        v2u w; w.x = pk2(o[0], o[1]); w.y = pk2(o[2], o[3]); *(GAS v2u*)(ACT + ((size_t)g * 64 + j) * NFF + f) = w;
    }
}
__device__ __forceinline__ void late_convert(Frame& F, const In& I, unsigned char* ws, int rank, int nranks) {
    const int gw = rank * NWAVES + F.wave, NGW = nranks * NWAVES, lane = F.lane;
    bf16* Wdn_t = (bf16*)(ws + WS_WDN); unsigned char* Wpg8_t = ws + WS_WPG;
    constexpr int I_DN = 64 * 172, I_PG = 64 * 64;
    for (int it = gw; it < I_DN + I_PG; it += NGW) {
        int r = it;
        if (r < I_DN) { const int n0 = 64 * (r / 172), k0 = 64 * (r % 172); xpose_item2(I.w_down, n0, I.w_down, n0 + 32, 4096, nullptr, Wdn_t, NFF, n0, k0, lane); continue; } r -= I_DN;
        { const int n0 = 64 * (r >> 6), k0 = 64 * (r & 63); f32x4 va[8], vb[8]; xpose_load(I.w_pg, 4096, n0, k0, lane, va); xpose_load(I.w_pg, 4096, n0 + 32, k0, lane, vb);
            xpose_store8(va, I.g_ple, pg8::W8_SCALE, Wpg8_t, 4096, n0, k0, lane); xpose_store8(vb, I.g_ple, pg8::W8_SCALE, Wpg8_t, 4096, n0 + 32, k0, lane); }
    }
}

__device__ __forceinline__ void final_norm(Frame& F, const In& I, float* out, const float* ssq3) {
    const int gw = F.vcu * NWAVES + F.wave, NGW = F.G * NWAVES, lane = F.lane;
    for (int m = gw; m < M; m += NGW) {
        const float rstd = 1.0f / sqrtf(ssq3[m] * (1.0f / DM) + 1e-6f);
        GAS f32x4* xr = (GAS f32x4*)(out + (size_t)m * DM) + lane; const GAS f32x4* gr = (const GAS f32x4*)I.g_final + lane;
#pragma unroll
        for (int j = 0; j < 16; ++j) { const f32x4 v = xr[64 * j], g = gr[64 * j]; xr[64 * j] = v * rstd * g; }
    }
}

constexpr int N_PHASES = 10;
#ifndef REP_QKV
#define REP_QKV 0
#ifndef REP_RET
#define REP_RET 0
#endif
#endif
#ifndef P5_ASM
#define P5_ASM 0
#endif
#ifndef ALIGNV
#define ALIGNV true
#endif
#ifndef SP2V
#define SP2V true
#endif
__global__ void __launch_bounds__(NWAVES * 64, 2) fwd_kernel(Args args) {
    extern __shared__ __attribute__((aligned(16))) unsigned char lds_raw[];
    Frame F;
    F.lds = (LAS unsigned char*)lds_raw;
    F.tid = threadIdx.x; F.lane = F.tid & 63; F.wave = __builtin_amdgcn_readfirstlane(F.tid >> 6);
    F.G = gridDim.x; { const int bx = blockIdx.x; F.vcu = (F.G % 8 == 0) ? (bx % 8) * (F.G / 8) + bx / 8 : bx; }
    unsigned char* ws = args.ws; const In& I = args.in;
    gu32* ctl = (gu32*)(ws + WS_CTL);
    volatile LAS unsigned* MISC = (volatile LAS unsigned*)(F.lds + MISC_OFF);
    for (int u = F.tid; u < (LDS_BYTES - LDSCTL_OFF) / 4; u += NWAVES * 64) ((LAS unsigned*)(F.lds + LDSCTL_OFF))[u] = 0u;
    __syncthreads();
    const int lo = args.ph_lo, hi = args.ph_hi;
    const bool one_phase = (hi - lo) == 1;
    XcdBarrier bar; bar.bar = (unsigned*)(ctl + CW_BAR); bar.x = 0; bar.st = nullptr;
    if (!one_phase) bar = xcd_barrier_post((unsigned*)(ctl + CW_BAR), MISC + 8);
#ifndef ONLY_PHASE
#define ONLY_PHASE -1
#endif
#define IN(k) ((ONLY_PHASE < 0 || ONLY_PHASE == (k)) && lo <= (k) && (k) < hi)
#define SEAM(k) do { if (IN(k) && IN((k) + 1)) xcd_barrier(bar); } while (0)
    float* ssq_cq = (float*)(ws + WS_CTL + CTL_SSQ); float* ssq_ckv = ssq_cq + M; float* ssq1 = ssq_ckv + M; float* ssq2 = ssq1 + M; float* ssq3 = ssq2 + M;
    bf16* XB = (bf16*)(ws + WS_XB); bf16* PJ = (bf16*)(ws + WS_PROJ); bf16* HB = (bf16*)(ws + WS_HB); bf16* ACT = (bf16*)(ws + WS_ACT); bf16* PP = (bf16*)(ws + WS_PP);
    const float* cosR = (const float*)(ws + WS_COSR); const float* sinR = (const float*)(ws + WS_SINR); const float* cosM = (const float*)(ws + WS_COSM); const float* sinM = (const float*)(ws + WS_SINM);

    const int cv_rem = (64 * 7) % F.G;
    if (IN(0)) { p0_prologue(F, I, ws); SEAM(0); }
    if (IN(1)) {
        { pg8::Gemm g{XB, (const bf16*)(ws + WS_WIN), M, 8192, DM, DM, DM}; pg8::StaticOrder S; S.init(M, 8192, F.G, (int)blockIdx.x);
          pg8::EpiProj E{PJ, LDP, cosR, sinR};
          pg8::gemm_phase<pg8::EpiProj, pg8::StaticOrder, ALIGNV, SP2V>(F.lds, g, S, E); }
        { pg8::Gemm8 g{ws + WS_XB8, ws + WS_WIN8, M, 1792, DM, DM, DM}; pg8::StaticOrder S; S.init(M, 1792, F.G, (int)blockIdx.x);
          pg8::EpiC8 E{ws + WS_C8, ws + WS_KR, ssq_cq, ssq_ckv, cosM, sinM};
          pg8::gemm_phase8<pg8::EpiC8, pg8::StaticOrder, true>(F.lds, g, S, E); }
        if (cv_rem == 0) pre_convert(F, I, ws, (int)blockIdx.x, F.G, CV_PRE);
        else if ((int)blockIdx.x >= cv_rem) pre_convert(F, I, ws, (int)blockIdx.x - cv_rem, F.G - cv_rem, CV_PRE);
        SEAM(1);
    }
    if (IN(2)) {
        retention_phase(F, I, ws, CV_PRE);
#if REP_RET
        retention_phase(F, I, ws, REP_RET == 2 ? CV_PRE : CV_N);
#endif
        { pg8::Gemm8 g{ws + WS_C8, ws + WS_WUQ, M, 3072, 1024, 1536, 1024}; pg8::StaticOrder S; S.init(M, 3072, F.G, (int)blockIdx.x);
          pg8::EpiQ E{ws + WS_Q, ssq_cq, cosM, sinM};
          pg8::gemm_phase8<pg8::EpiQ, pg8::StaticOrder, true>(F.lds, g, S, E); }
        { pg8::Gemm8 g{ws + WS_C8 + 1024, ws + WS_WUKV, M, 4096, 512, 1536, 512}; pg8::StaticOrder S; S.init(M, 4096, F.G, (int)blockIdx.x);
          pg8::EpiKV E{ws + WS_KB, ws + WS_VB, ssq_ckv};
          pg8::gemm_phase8<pg8::EpiKV, pg8::StaticOrder, true>(F.lds, g, S, E); }
#if REP_QKV
        { pg8::Gemm8 g{ws + WS_C8, ws + WS_WUQ, M, 3072, 1024, 1536, 1024}; pg8::StaticOrder S; S.init(M, 3072, F.G, (int)blockIdx.x);
          pg8::EpiQ E{ws + WS_Q, ssq_cq, cosM, sinM};
          pg8::gemm_phase8<pg8::EpiQ, pg8::StaticOrder, true>(F.lds, g, S, E); }
        { pg8::Gemm8 g{ws + WS_C8 + 1024, ws + WS_WUKV, M, 4096, 512, 1536, 512}; pg8::StaticOrder S; S.init(M, 4096, F.G, (int)blockIdx.x);
          pg8::EpiKV E{ws + WS_KB, ws + WS_VB, ssq_ckv};
          pg8::gemm_phase8<pg8::EpiKV, pg8::StaticOrder, true>(F.lds, g, S, E); }
#endif
        SEAM(2);
    }
#ifndef REP_ATT
#define REP_ATT 0
#endif
    if (IN(3)) { ro_finalize(F, ws); attn_phase<0>(F, ws); if (REP_ATT) attn_phase<REP_ATT>(F, ws); SEAM(3); }
    if (IN(4)) {
        pg8::Gemm8 g{ws + WS_XB, ws + WS_WO, M, DM, 6144, 6144, 6144}; pg8::StaticOrder S; S.init(M, DM, F.G, (int)blockIdx.x);
        pg8::EpiResT<false> E{I.x, HB, ssq1, nullptr};
        pg8::gemm_phase8<pg8::EpiResT<false>, pg8::StaticOrder, true, 32, 0x79797979, 0x7b7b7b7b>(F.lds, g, S, E);
        SEAM(4);
    }
    if (IN(5)) {
        pg8::StaticOrder S; S.init(M, 22016, F.G, (int)blockIdx.x);
        pg8::EpiGU E{ACT, ssq1, I.conv_w, I.conv_b, (float*)(ws + WS_GT), (float*)(ws + WS_GH), (float*)(ws + WS_UH)};
#if P5_ASM
        { pg8::Gemm8 g{(const unsigned char*)HB, ws + WS_WGU, M, 22016, 2 * DM, 2 * DM, 2 * DM};
          pg8::gemm_phase8<pg8::EpiGU, pg8::StaticOrder, true, 64>(F.lds, g, S, E); }
#else
        { pg8::Gemm g{HB, (const bf16*)(ws + WS_WGU), M, 22016, DM, DM, DM};
          pg8::gemm_phase<pg8::EpiGU, pg8::StaticOrder, ALIGNV, SP2V>(F.lds, g, S, E); }
#endif
        { constexpr int nwg = 64 * 86; const int G = F.G, c = (int)blockIdx.x, rem = nwg % G;
          const int rank = rem == 0 ? c : c - rem, nranks = rem == 0 ? G : G - rem;
          if (rem == 0 || c >= rem) { late_convert(F, I, ws, rank, nranks);
            pg8::Gemm gp{(const bf16*)(ws + WS_PB), (const bf16*)(ws + WS_WPP), M, DM, 256, 256, 256}; pg8::StaticOrder Sp; Sp.init(M, DM, nranks, rank);
            pg8::EpiPlain Ep{PP, DM};
            pg8::gemm_phase<pg8::EpiPlain, pg8::StaticOrder, ALIGNV, SP2V>(F.lds, gp, Sp, Ep); } }
        SEAM(5);
    }
    if (IN(6)) { fixup_phase(F, I, ws); SEAM(6); }
    if (IN(7)) {
        { pg8::Gemm g{ACT, (const bf16*)(ws + WS_WDN), M, DM, NFF, NFF, NFF}; pg8::StaticOrder S; S.init(M, DM, F.G, (int)blockIdx.x);
          pg8::EpiResT<true> E{nullptr, HB, ssq2, ws + WS_H8};
          pg8::gemm_phase<pg8::EpiResT<true>, pg8::StaticOrder, ALIGNV, SP2V>(F.lds, g, S, E); }
        SEAM(7);
    }
    const bool fuse_final = (F.G == 256);
    if (IN(8)) {
        pg8::Gemm8 g{ws + WS_H8, ws + WS_WPG, M, DM, DM, DM, DM};
        if (fuse_final) { pg8::PanelOrder S{(int)blockIdx.x}; pg8::EpiPleFinal E{args.out, HB, PP, ssq2, ssq3, (unsigned*)(ws + WS_CTL + CTL_PCNT), I.g_final};
            pg8::gemm_phase8<pg8::EpiPleFinal, pg8::PanelOrder, true>(F.lds, g, S, E); }
        else { pg8::StaticOrder S; S.init(M, DM, F.G, (int)blockIdx.x); pg8::EpiPle E{args.out, HB, PP, ssq2, ssq3};
            pg8::gemm_phase8<pg8::EpiPle, pg8::StaticOrder, true>(F.lds, g, S, E); SEAM(8); }
    }
    if (IN(9) && !fuse_final) final_norm(F, I, args.out, ssq3);
#undef IN
#undef SEAM
}

#ifndef MK_SPLIT
#define MK_SPLIT 0
#endif
extern "C" void kernel_launch(void* const* d_in, const int* in_sizes, int n_in, void* d_out, int out_size, void* d_ws, size_t ws_size, hipStream_t stream) {
    static int grid = 0;
    if (grid == 0) {
        if (n_in != 19 || out_size != M * DM || ws_size < WS_END) { fprintf(stderr, "kernel_launch: unexpected shapes (n_in %d, out %d, ws %zu)\n", n_in, out_size, ws_size); grid = -1; return; }
        int dev = 0, cus = 0, per_cu = 0;
        if (hipGetDevice(&dev) != hipSuccess || hipDeviceGetAttribute(&cus, hipDeviceAttributeMultiprocessorCount, dev) != hipSuccess) { grid = -1; return; }
        if (hipFuncSetAttribute((const void*)fwd_kernel, hipFuncAttributeMaxDynamicSharedMemorySize, LDS_BYTES) != hipSuccess) { fprintf(stderr, "kernel_launch: hipFuncSetAttribute failed\n"); grid = -1; return; }
        if (hipOccupancyMaxActiveBlocksPerMultiprocessor(&per_cu, (const void*)fwd_kernel, NWAVES * 64, LDS_BYTES) != hipSuccess || per_cu < 1) { fprintf(stderr, "kernel_launch: occupancy query says %d\n", per_cu); }
        (void)hipGetLastError();
        grid = cus;
    }
    if (grid < 0) return;
    if (hipMemsetAsync((char*)d_ws + WS_CTL, 0, CTL_ZERO_BYTES, stream) != hipSuccess) return;
    Args a{};
    const float** ip = (const float**)&a.in;
    for (int i = 0; i < 19; ++i) ip[i] = (const float*)d_in[i];
    a.out = (float*)d_out; a.ws = (unsigned char*)d_ws;
#if MK_SPLIT
    for (int ph = 0; ph < N_PHASES; ++ph) { a.ph_lo = ph; a.ph_hi = ph + 1; hipLaunchKernelGGL(fwd_kernel, dim3(grid), dim3(NWAVES * 64), LDS_BYTES, stream, a); }
#else
    a.ph_lo = 0; a.ph_hi = N_PHASES;
    hipLaunchKernelGGL(fwd_kernel, dim3(grid), dim3(NWAVES * 64), LDS_BYTES, stream, a);
#endif
}
```
